# Optimizing an MI355X kernel written in HIP

```python
import math
import jax
import jax.numpy as jnp
from jax import lax
import numpy as np

D_MODEL = 2048
BATCH = 4
SEQ = 4096
DEPTH = 2

GRID_W = 64
CTX_LEN = 256
D_MIX = D_MODEL
HY_W = D_MIX // 4
RW_W = D_MIX // 4
GD_W = D_MIX // 4
RG_W = D_MIX - HY_W - RW_W - GD_W
D_FF = 4 * D_MODEL
NORM_EPS = 1e-6

HY_SHORT = 3
HY_EMB = 33
HY_BANDS = (HY_EMB - 1) // 2
HY_FILT = 64
HY_DECAY_TARGET = 1e-2
HY_FAST_PCT = 0.3
HY_SLOW_PCT = 1.5
HY_IN = 3 * HY_W

RW_HEAD = 64
RW_HEADS = RW_W // RW_HEAD
RW_LORA_W = 64
RW_LORA_A = 64
RW_LORA_G = 128
RW_GN_EPS = 64e-5
RW_IN = 3 * RW_W + RW_LORA_W + RW_LORA_A + RW_LORA_G
RW_SPLITS = (RW_W, 2 * RW_W, 3 * RW_W, 3 * RW_W + RW_LORA_W, 3 * RW_W + RW_LORA_W + RW_LORA_A)

GD_HEAD = 128
GD_HEADS = GD_W // GD_HEAD
GD_CHUNK = 64
GD_IN = 4 * GD_W + 4 * GD_HEADS

RG_BLOCKS = 4
RG_BLOCK = RG_W // RG_BLOCKS
RG_C = 8.0
RG_IN = 2 * RG_W

SHORT_CONV = 4
SHORT_PAD = 2

N_IN = HY_IN + RW_IN + GD_IN + RG_IN
IN_SPLITS = (HY_IN, HY_IN + RW_IN, HY_IN + RW_IN + GD_IN)

kernel_name = 'hybrid_parallel_mixer_dit'


def _rmsnorm(x, g):
    xf = x.astype(jnp.float32)
    y = xf * lax.rsqrt(jnp.mean(xf * xf, axis=-1, keepdims=True) + NORM_EPS)
    return (y * g.astype(jnp.float32)).astype(x.dtype)


def _modulation(cond, ada_w, ada_b):
    return jnp.split(jax.nn.silu(cond) @ ada_w + ada_b, 6, axis=-1)


def _modulate(h, shift, scale):
    return h * (1 + scale) + shift


def _flip_if(t, d):
    return t if d == 0 else jnp.flip(t, axis=1)


def _short_conv(u, w, n_rows, row_len, pad_left):
    bsz, _, ch = u.shape
    width = w.shape[0]
    ur = u.reshape(bsz, n_rows, row_len, ch)
    up = jnp.pad(ur, ((0, 0), (0, 0), (pad_left, width - 1 - pad_left), (0, 0)))
    y = up[:, :, 0:row_len] * w[0]
    for j in range(1, width):
        y = y + up[:, :, j:j + row_len] * w[j]
    return y.reshape(bsz, n_rows * row_len, ch)


def _mlp(h, w1, w2):
    return jnp.square(jax.nn.relu(h @ w1)) @ w2


def _hyena_filter(length, w1, b1, w2, b2, w3, freq):
    t = jnp.arange(length, dtype=jnp.float32)
    z = t / max(length - 1, 1)
    bands = jnp.linspace(1e-4, HY_BANDS - 1, HY_BANDS, dtype=jnp.float32)
    ang = (2.0 * math.pi / length) * t[:, None] * bands[None, :]
    feat = jnp.concatenate([z[:, None], jnp.cos(ang), -jnp.sin(ang)], axis=-1)
    h = jnp.sin(freq[0] * (feat @ w1 + b1))
    h = jnp.sin(freq[1] * (h @ w2 + b2))
    h = (h @ w3).astype(jnp.float32)
    deltas = jnp.abs(jnp.linspace(math.log(HY_DECAY_TARGET) / HY_SLOW_PCT,
                                  math.log(HY_DECAY_TARGET) / HY_FAST_PCT, HY_W, dtype=jnp.float32))
    h = h * jnp.exp(-z[:, None] * jnp.tile(deltas, 2)[None, :])
    h_fwd, h_bwd = h[:, :HY_W], h[:, HY_W:]
    filt = jnp.concatenate([h_fwd, jnp.zeros((1, HY_W), jnp.float32), h_bwd[:0:-1]], axis=0)
    return filt / jnp.sum(jnp.abs(filt), axis=0, keepdims=True)


def _hyena_mixer(p, n_rows, row_len, conv_w, w1, b1, w2, b2, w3, freq, skip):
    length = p.shape[1]
    u = _short_conv(p, conv_w, n_rows, row_len, 1)
    v, x0, x1 = jnp.split(u.astype(jnp.float32), 3, axis=-1)
    filt = _hyena_filter(length, w1, b1, w2, b2, w3, freq)
    zin = x1 * v
    zf = jnp.fft.rfft(zin, n=2 * length, axis=1)
    y = jnp.fft.irfft(zf * jnp.fft.rfft(filt, axis=0)[None], n=2 * length, axis=1)[:, :length]
    y = y + zin * skip
    return (x0 * y).astype(p.dtype)


def _rwkv7_direction(p, s0, mu, w0, w_up, a0, a_up, g_up, k_k, k_a, r_k, ln_g, ln_b, with_out):
    bsz, length, _ = p.shape
    p = p.astype(jnp.float32)
    prev = jnp.pad(p, ((0, 0), (1, 0), (0, 0)))[:, :-1]
    pm = p + (prev - p) * mu
    r, k, v, xw, xa, xg = jnp.split(pm, RW_SPLITS, axis=-1)
    decay = jnp.exp(-jnp.exp(-jax.nn.softplus(-(w0 + jnp.tanh(xw) @ w_up)) - 0.5))
    a = jax.nn.sigmoid(a0 + xa @ a_up)
    kk = (k * k_k).reshape(bsz, length, RW_HEADS, RW_HEAD)
    kk = kk / jnp.maximum(jnp.linalg.norm(kk, axis=-1, keepdims=True), 1e-12)
    k = k * (1 + (a - 1) * k_a)

    def heads(t):
        return jnp.moveaxis(t.reshape(bsz, length, RW_HEADS, RW_HEAD), 1, 0)

    seqs = [heads(decay), heads(k), heads(v), jnp.moveaxis(kk, 1, 0), heads(a)]
    if with_out:
        seqs.append(heads(r))

    def step(state, inp):
        w_t, k_t, v_t, kk_t, a_t = inp[:5]
        sk = jnp.einsum('bhvk,bhk->bhv', state, kk_t)
        state = (state * w_t[:, :, None, :] - sk[..., None] * (kk_t * a_t)[:, :, None, :]
                 + v_t[..., None] * k_t[:, :, None, :])
        y = jnp.einsum('bhvk,bhk->bhv', state, inp[5]) if with_out else None
        return state, y

    s_fin, ys = lax.scan(step, s0, tuple(seqs))
    if not with_out:
        return None, s_fin
    y = jnp.moveaxis(ys, 0, 1)
    mean = jnp.mean(y, axis=-1, keepdims=True)
    var = jnp.mean(jnp.square(y - mean), axis=-1, keepdims=True)
    yn = ((y - mean) * lax.rsqrt(var + RW_GN_EPS)).reshape(bsz, length, RW_W) * ln_g + ln_b
    bonus = (jnp.sum((r * k * r_k).reshape(bsz, length, RW_HEADS, RW_HEAD), axis=-1, keepdims=True)
             * v.reshape(bsz, length, RW_HEADS, RW_HEAD)).reshape(bsz, length, RW_W)
    g = jax.nn.sigmoid(xg) @ g_up
    return (yn + bonus) * g, s_fin


def _rwkv7_mixer(p, s0s, prm, with_out):
    bsz = p.shape[0]
    outs, states = [], []
    for d in range(2):
        s0 = jnp.zeros((bsz, RW_HEADS, RW_HEAD, RW_HEAD), jnp.float32) if s0s is None else s0s[d]
        o, s = _rwkv7_direction(_flip_if(p, d), s0, *[t[d] for t in prm], with_out)
        outs.append(o)
        states.append(s)
    if not with_out:
        return None, states
    return (outs[0] + jnp.flip(outs[1], axis=1)).astype(p.dtype), states


def _l2norm(t):
    return t * lax.rsqrt(jnp.sum(t * t, axis=-1, keepdims=True) + 1e-6)


def _gdn_direction(q, k, v, g_raw, b_raw, s0, a_log, dt_bias, with_out):
    bsz, length, nh, _ = q.shape
    nc = length // GD_CHUNK
    g = -jnp.exp(a_log) * jax.nn.softplus(g_raw + dt_bias)
    beta = jax.nn.sigmoid(b_raw)

    def chunks(t):
        t = t.reshape((bsz, nc, GD_CHUNK, nh) + t.shape[3:])
        return jnp.moveaxis(jnp.moveaxis(t, 3, 2), 1, 0)

    qc, kc, vc = chunks(q), chunks(k), chunks(v)
    gc = jnp.cumsum(chunks(g), axis=-1)
    bc = chunks(beta)[..., None]
    idx = jnp.arange(GD_CHUNK)
    lower = idx[:, None] >= idx[None, :]
    decay_in = jnp.exp(jnp.where(lower, gc[..., :, None] - gc[..., None, :], -jnp.inf))
    decay_strict = jnp.where(idx[:, None] > idx[None, :], decay_in, 0.0)
    kb = kc * bc
    tmat = jnp.einsum('nbhik,nbhjk->nbhij', kb, kc) * decay_strict + jnp.eye(GD_CHUNK, dtype=jnp.float32)
    rhs = jnp.concatenate([vc * bc, kb * jnp.exp(gc)[..., None]], axis=-1)
    sol = lax.linalg.triangular_solve(tmat, rhs, left_side=True, lower=True, unit_diagonal=True)
    u, w = sol[..., :GD_HEAD], sol[..., GD_HEAD:]
    g_last = gc[..., -1]
    k_dec = kc * jnp.exp(g_last[..., None] - gc)[..., None]
    seqs = [u, w, k_dec, g_last]
    if with_out:
        seqs += [qc * jnp.exp(gc)[..., None], jnp.einsum('nbhik,nbhjk->nbhij', qc, kc) * decay_in]

    def step(state, inp):
        u_c, w_c, kd_c, gl_c = inp[:4]
        v_new = u_c - w_c @ state
        new_state = state * jnp.exp(gl_c)[..., None, None] + jnp.einsum('bhck,bhcv->bhkv', kd_c, v_new)
        o = (inp[4] @ state + inp[5] @ v_new) if with_out else None
        return new_state, o

    s_fin, o = lax.scan(step, s0, tuple(seqs))
    if not with_out:
        return None, s_fin
    o = jnp.swapaxes(jnp.moveaxis(o, 0, 1), 2, 3).reshape(bsz, length, nh, GD_HEAD)
    return o, s_fin


def _gdn_mixer(p, n_rows, row_len, s0s, conv_w, a_log, dt_bias, norm_g, with_out):
    bsz, length, _ = p.shape
    qkv = jax.nn.silu(_short_conv(p[..., :3 * GD_W], conv_w, n_rows, row_len, SHORT_PAD)).astype(jnp.float32)
    q, k, v = [t.reshape(bsz, length, GD_HEADS, GD_HEAD) for t in jnp.split(qkv, 3, axis=-1)]
    q = _l2norm(q) * GD_HEAD ** -0.5
    k = _l2norm(k)
    gb = p[..., 4 * GD_W:].astype(jnp.float32).reshape(bsz, length, 4, GD_HEADS)
    outs, states = [], []
    for d in range(2):
        s0 = jnp.zeros((bsz, GD_HEADS, GD_HEAD, GD_HEAD), jnp.float32) if s0s is None else s0s[d]
        o, s = _gdn_direction(_flip_if(q, d), _flip_if(k, d), _flip_if(v, d), _flip_if(gb[:, :, d], d),
                              _flip_if(gb[:, :, 2 + d], d), s0, a_log[d], dt_bias[d], with_out)
        outs.append(o)
        states.append(s)
    if not with_out:
        return None, states
    o = outs[0] + jnp.flip(outs[1], axis=1)
    o = o * lax.rsqrt(jnp.mean(o * o, axis=-1, keepdims=True) + NORM_EPS) * norm_g
    out = o.reshape(bsz, length, GD_W) * jax.nn.silu(p[..., 3 * GD_W:4 * GD_W].astype(jnp.float32))
    return out.astype(p.dtype), states


def _lin_combine(left, right):
    a1, b1 = left
    a2, b2 = right
    return a1 * a2, a2 * b1 + b2


def _rglru_direction(xc, h0, wa, ba, wx, bx, lam):
    bsz, length, _ = xc.shape
    xb = xc.reshape(bsz, length, RG_BLOCKS, RG_BLOCK)
    gate_r = jax.nn.sigmoid(jnp.einsum('blni,nij->blnj', xb, wa).reshape(bsz, length, RG_W) + ba)
    gate_i = jax.nn.sigmoid(jnp.einsum('blni,nij->blnj', xb, wx).reshape(bsz, length, RG_W) + bx)
    log_a = -RG_C * gate_r * jax.nn.softplus(-lam)
    a = jnp.exp(log_a)
    b = jnp.sqrt(-jnp.expm1(2 * log_a)) * (gate_i * xc)
    b = b.at[:, 0].add(a[:, 0] * h0)
    _, h = lax.associative_scan(_lin_combine, (a, b), axis=1)
    return h, h[:, -1]


def _rglru_mixer(p, n_rows, row_len, h0s, conv_w, conv_b, wa, ba, wx, bx, lam, with_out):
    bsz = p.shape[0]
    xc = (_short_conv(p[..., :RG_W], conv_w, n_rows, row_len, SHORT_PAD) + conv_b).astype(jnp.float32)
    hs, states = [], []
    for d in range(2):
        h0 = jnp.zeros((bsz, RG_W), jnp.float32) if h0s is None else h0s[d]
        h, s = _rglru_direction(_flip_if(xc, d), h0, wa[d], ba[d], wx[d], bx[d], lam[d])
        hs.append(h)
        states.append(s)
    if not with_out:
        return None, states
    out = jax.nn.gelu(p[..., RG_W:].astype(jnp.float32)) * (hs[0] + jnp.flip(hs[1], axis=1))
    return out.astype(p.dtype), states


def setup_inputs(seed: int = 0) -> dict:
    key = jax.random.key(seed)
    keys = list(jax.random.split(key, 64))

    def nrm(shape, scale):
        return scale * jax.random.normal(keys.pop(), shape, jnp.float32)

    def uni(shape, lo, hi):
        return jax.random.uniform(keys.pop(), shape, jnp.float32, lo, hi)

    def gain(shape):
        return 1.0 + nrm(shape, 0.02)

    dt = jnp.exp(uni((DEPTH, 2, GD_HEADS), math.log(1e-3), math.log(1e-1)))
    a_pow = uni((DEPTH, 2, RG_W), 0.9, 0.999)
    a_base = a_pow ** (1.0 / RG_C)
    return {
        'x': nrm((BATCH, SEQ, D_MODEL), 1.0),
        'c': nrm((BATCH, D_MODEL), 1.0),
        'ctx': nrm((BATCH, CTX_LEN, D_MODEL), 1.0),
        'c_ctx': nrm((D_MODEL,), 1.0),
        'ada_w': nrm((DEPTH, D_MODEL, 6 * D_MODEL), 0.5 * D_MODEL ** -0.5),
        'ada_b': nrm((DEPTH, 6 * D_MODEL), 0.01),
        'norm_mix_g': gain((DEPTH, D_MODEL)),
        'norm_mlp_g': gain((DEPTH, D_MODEL)),
        'w_in': nrm((DEPTH, D_MODEL, N_IN), D_MODEL ** -0.5),
        'w_out': nrm((DEPTH, D_MIX, D_MODEL), D_MIX ** -0.5),
        'hy_conv': nrm((DEPTH, HY_SHORT, HY_IN), HY_SHORT ** -0.5),
        'hy_w1': nrm((DEPTH, HY_EMB, HY_FILT), HY_EMB ** -0.5),
        'hy_b1': nrm((DEPTH, HY_FILT), 0.1),
        'hy_w2': nrm((DEPTH, HY_FILT, HY_FILT), HY_FILT ** -0.5),
        'hy_b2': nrm((DEPTH, HY_FILT), 0.1),
        'hy_w3': nrm((DEPTH, HY_FILT, 2 * HY_W), HY_FILT ** -0.5),
        'hy_freq': gain((DEPTH, 2, HY_FILT)),
        'hy_skip': nrm((DEPTH, HY_W), 1.0),
        'rw_mu': uni((DEPTH, 2, RW_IN), 0.0, 1.0),
        'rw_w0': uni((DEPTH, 2, RW_W), -3.0, 2.0),
        'rw_w_up': nrm((DEPTH, 2, RW_LORA_W, RW_W), 0.1 * RW_LORA_W ** -0.5),
        'rw_a0': nrm((DEPTH, 2, RW_W), 0.5),
        'rw_a_up': nrm((DEPTH, 2, RW_LORA_A, RW_W), 0.1 * RW_LORA_A ** -0.5),
        'rw_g_up': nrm((DEPTH, 2, RW_LORA_G, RW_W), RW_LORA_G ** -0.5),
        'rw_k_k': 0.85 + nrm((DEPTH, 2, RW_W), 0.02),
        'rw_k_a': gain((DEPTH, 2, RW_W)),
        'rw_r_k': nrm((DEPTH, 2, RW_W), 0.1),
        'rw_ln_g': gain((DEPTH, 2, RW_W)),
        'rw_ln_b': nrm((DEPTH, 2, RW_W), 0.01),
        'gd_conv': nrm((DEPTH, SHORT_CONV, 3 * GD_W), 0.5),
        'gd_a_log': jnp.log(uni((DEPTH, 2, GD_HEADS), 1.0, 16.0)),
        'gd_dt_bias': dt + jnp.log(-jnp.expm1(-dt)),
        'gd_norm_g': gain((DEPTH, GD_HEAD)),
        'rg_conv': nrm((DEPTH, SHORT_CONV, RG_W), 0.5),
        'rg_conv_b': nrm((DEPTH, RG_W), 0.01),
        'rg_wa': nrm((DEPTH, 2, RG_BLOCKS, RG_BLOCK, RG_BLOCK), RG_BLOCK ** -0.5),
        'rg_ba': nrm((DEPTH, 2, RG_W), 0.01),
        'rg_wx': nrm((DEPTH, 2, RG_BLOCKS, RG_BLOCK, RG_BLOCK), RG_BLOCK ** -0.5),
        'rg_bx': nrm((DEPTH, 2, RG_W), 0.01),
        'rg_lambda': jnp.log(a_base) - jnp.log1p(-a_base),
        'mlp_w1': nrm((DEPTH, D_MODEL, D_FF), D_MODEL ** -0.5),
        'mlp_w2': nrm((DEPTH, D_FF, D_MODEL), D_FF ** -0.5),
        'final_norm_g': gain((D_MODEL,)),
    }


def reference(x, c, ctx, c_ctx, ada_w, ada_b, norm_mix_g, norm_mlp_g, w_in, w_out,
              hy_conv, hy_w1, hy_b1, hy_w2, hy_b2, hy_w3, hy_freq, hy_skip,
              rw_mu, rw_w0, rw_w_up, rw_a0, rw_a_up, rw_g_up, rw_k_k, rw_k_a, rw_r_k, rw_ln_g, rw_ln_b,
              gd_conv, gd_a_log, gd_dt_bias, gd_norm_g,
              rg_conv, rg_conv_b, rg_wa, rg_ba, rg_wx, rg_bx, rg_lambda,
              mlp_w1, mlp_w2, final_norm_g):
    rows = x.shape[1] // GRID_W
    ctx_len = ctx.shape[1]
    for l in range(DEPTH):
        last = l == DEPTH - 1
        sh_x, sc_x, gt_x, sh2_x, sc2_x, gt2_x = _modulation(c[:, None, :], ada_w[l], ada_b[l])
        sh_c, sc_c, gt_c, sh2_c, sc2_c, gt2_c = _modulation(c_ctx[None, None, :], ada_w[l], ada_b[l])
        px = _modulate(_rmsnorm(x, norm_mix_g[l]), sh_x, sc_x) @ w_in[l]
        pc = _modulate(_rmsnorm(ctx, norm_mix_g[l]), sh_c, sc_c) @ w_in[l]
        px_hy, px_rw, px_gd, px_rg = jnp.split(px, IN_SPLITS, axis=-1)
        pc_hy, pc_rw, pc_gd, pc_rg = jnp.split(pc, IN_SPLITS, axis=-1)
        hy_prm = (hy_conv[l], hy_w1[l], hy_b1[l], hy_w2[l], hy_b2[l], hy_w3[l], hy_freq[l], hy_skip[l])
        rw_prm = (rw_mu[l], rw_w0[l], rw_w_up[l], rw_a0[l], rw_a_up[l], rw_g_up[l],
                  rw_k_k[l], rw_k_a[l], rw_r_k[l], rw_ln_g[l], rw_ln_b[l])
        gd_prm = (gd_conv[l], gd_a_log[l], gd_dt_bias[l], gd_norm_g[l])
        rg_prm = (rg_conv[l], rg_conv_b[l], rg_wa[l], rg_ba[l], rg_wx[l], rg_bx[l], rg_lambda[l])
        c_rw, s_rw = _rwkv7_mixer(pc_rw, None, rw_prm, not last)
        c_gd, s_gd = _gdn_mixer(pc_gd, 1, ctx_len, None, *gd_prm, not last)
        c_rg, s_rg = _rglru_mixer(pc_rg, 1, ctx_len, None, *rg_prm, not last)
        x_hy = _hyena_mixer(px_hy, rows, GRID_W, *hy_prm)
        x_rw, _ = _rwkv7_mixer(px_rw, s_rw, rw_prm, True)
        x_gd, _ = _gdn_mixer(px_gd, rows, GRID_W, s_gd, *gd_prm, True)
        x_rg, _ = _rglru_mixer(px_rg, rows, GRID_W, s_rg, *rg_prm, True)
        mix_x = jnp.concatenate([x_hy, x_rw, x_gd, x_rg], axis=-1) @ w_out[l]
        x_new = x + gt_x * mix_x
        x_new = x_new + gt2_x * _mlp(_modulate(_rmsnorm(x_new, norm_mlp_g[l]), sh2_x, sc2_x), mlp_w1[l], mlp_w2[l])
        if not last:
            c_hy = _hyena_mixer(pc_hy, 1, ctx_len, *hy_prm)
            mix_c = jnp.concatenate([c_hy, c_rw, c_gd, c_rg], axis=-1) @ w_out[l]
            ctx = ctx + gt_c * mix_c
            ctx = ctx + gt2_c * _mlp(_modulate(_rmsnorm(ctx, norm_mlp_g[l]), sh2_c, sc2_c), mlp_w1[l], mlp_w2[l])
        x = x_new
    return _rmsnorm(x, final_norm_g)
```

```cpp
#include <hip/hip_runtime.h>
#include <hip/hip_cooperative_groups.h>
#include <cstdio>
#include <cstdint>
namespace cg = cooperative_groups;
namespace pg8 {
#define PG8_LAS __attribute__((address_space(3)))
typedef unsigned short bf16_t;
typedef short bf16x8 __attribute__((ext_vector_type(8)));
typedef float f32x4 __attribute__((ext_vector_type(4)));
typedef unsigned u32x4 __attribute__((ext_vector_type(4)));
constexpr int BM = 256, BK = 64, HALF = 128, HTB = HALF * BK * 2  , STAGE_BYTES = 8 * HTB, NXCD = 8, WGM = 8;

__host__ __device__ __forceinline__ int lds_byte(int r, int c) { const int st = (r >> 4) * 2 + (c >> 5), rr = r & 15, cc = c & 31, ob = rr * 64 + cc * 2; return st * 1024 + (ob ^ (((ob >> 9) & 1) << 5)); }
__host__ __device__ __forceinline__ void stage_rc(int b, int& R, int& C) { const int st = b / 1024, sb = b % 1024, swz = sb ^ (((sb >> 9) & 1) << 5); R = (st >> 1) * 16 + swz / 64; C = (st & 1) * 32 + (swz % 64) / 2; }
__host__ __device__ __forceinline__ int perm32(int rho) { const int n = rho >> 4, i = rho & 15; return 8 * (i >> 2) + 4 * n + (i & 3); }

struct Unit { int pm, pn; };
struct Gemm { const bf16_t* A; const bf16_t* Bt; int M, N, K; };

struct StaticOrder {
    int nM, nN, nwg, G, c;
    __host__ __device__ void init(int M, int N, int G_, int c_) { nM = M / BM; nN = N / BM; nwg = nM * nN; G = G_; c = c_; }
    __host__ __device__ bool next(int i, Unit& u) const {
        const long L = (long)i * G + c; if (L >= nwg) return false;
        int wgid = (int)L; { const int q = nwg / NXCD, r = nwg % NXCD, xcd = wgid % NXCD, off = wgid / NXCD; wgid = (xcd < r ? xcd * (q + 1) : r * (q + 1) + (xcd - r) * q) + off; }
        const int nig = WGM * nN, gid = wgid / nig, fm = gid * WGM, gsz = (nM - fm) < WGM ? (nM - fm) : WGM;
        u.pm = fm + ((wgid % nig) % gsz); u.pn = (wgid % nig) / gsz; return true;
    }
    __device__ __forceinline__ void a_ready(const Unit&) const {}
    __device__ __forceinline__ void done(const Unit&) const {}
};

__device__ __forceinline__ unsigned cvt_pk_bf16(float lo, float hi) { unsigned r; asm volatile("v_cvt_pk_bf16_f32 %0, %1, %2" : "=v"(r) : "v"(lo), "v"(hi)); return r; }
typedef float f32x2 __attribute__((ext_vector_type(2)));
template <class Epi, class Sched, bool ALIGN_EPI = false, bool SP2 = false>
__device__ __forceinline__ void gemm_phase(PG8_LAS unsigned char* lds, const Gemm g, const Sched& S, const Epi& E) {
    const int tid = threadIdx.x, wid = __builtin_amdgcn_readfirstlane(tid >> 6), lane = tid & 63, wr = wid >> 2, wc = wid & 3, fr = lane & 15, fq = lane >> 4;
    const int K = g.K, nt = K / BK;
    unsigned voffA[2], voffB[2];
#pragma unroll
    for (int i = 0; i < 2; ++i) { int R, C; stage_rc(tid * 16 + i * 8192, R, C); const int Rb = Epi::PERM ? ((R & ~31) + perm32(R & 31)) : R;
        voffA[i] = (unsigned)(R * K + C) * 2u; voffB[i] = (unsigned)(Rb * K + C) * 2u; }
    const size_t kstep = (size_t)(BK * 2);
    const size_t hstep = (size_t)HALF * K * 2;
    const size_t tstep = 2 * hstep;
    const unsigned ldsw = (unsigned)wid * 1024u;
    const int aoff = lds_byte(wr * 64 + fr, fq * 8), boff = lds_byte(wc * 32 + fr, fq * 8);
#define PG8_SA(b, h) (((b) * 2 + (h)) * HTB)
#define PG8_SB(b, h) ((4 + (b) * 2 + (h)) * HTB)
#define PG8_STAGE(bufoff, gbase, voff) do { _Pragma("unroll") for (int _i = 0; _i < 2; ++_i) \
        __builtin_amdgcn_global_load_lds((const unsigned*)((const char*)(gbase) + (voff)[_i]), (PG8_LAS unsigned*)(lds + (bufoff) + ldsw + _i * 8192), 16, 0, 0); } while (0)
#define PG8_LDA(dst, b, h) do { _Pragma("unroll") for (int m = 0; m < 4; ++m) _Pragma("unroll") for (int k = 0; k < 2; ++k) dst[m][k] = *(const PG8_LAS bf16x8*)(lds + PG8_SA(b, h) + aoff + m * 2048 + k * 1024); } while (0)
#define PG8_LDB(dst, b, h) do { _Pragma("unroll") for (int n = 0; n < 2; ++n) _Pragma("unroll") for (int k = 0; k < 2; ++k) dst[n][k] = *(const PG8_LAS bf16x8*)(lds + PG8_SB(b, h) + boff + n * 2048 + k * 1024); } while (0)
#define PG8_MMA(ai, bj, At, Bt) do { __builtin_amdgcn_s_setprio(1); _Pragma("unroll") for (int m = 0; m < 4; ++m) _Pragma("unroll") for (int n = 0; n < 2; ++n) _Pragma("unroll") for (int k = 0; k < 2; ++k) \
        acc[ai][bj][m][n] = __builtin_amdgcn_mfma_f32_16x16x32_bf16(Bt[n][k], At[m][k], acc[ai][bj][m][n], 0, 0, 0); __builtin_amdgcn_s_setprio(0); } while (0)
#define PG8_WAIT_V(n) asm volatile("s_waitcnt vmcnt(" #n ")" ::: "memory")
#define PG8_WAIT_L(n) asm volatile("s_waitcnt lgkmcnt(" #n ")" ::: "memory")
#define PG8_BAR __builtin_amdgcn_s_barrier()
#define PG8_SCHED __builtin_amdgcn_sched_barrier(0)
    Unit cur, nxt; int ui = 0;
    if (!S.next(0, cur)) return;
    f32x4 acc[2][2][4][2];
#pragma unroll
    for (int a = 0; a < 2; ++a)
#pragma unroll
        for (int b = 0; b < 2; ++b)
#pragma unroll
            for (int m = 0; m < 4; ++m)
#pragma unroll
                for (int n = 0; n < 2; ++n) acc[a][b][m][n] = (f32x4){0.f, 0.f, 0.f, 0.f};
    bf16x8 At[4][2], B0[2][2], B1[2][2];
    const char* cA = (const char*)g.A + (size_t)cur.pm * tstep; const char* cB = (const char*)g.Bt + (size_t)cur.pn * tstep;
    S.a_ready(cur);
    if constexpr (SP2) {
        PG8_STAGE(PG8_SB(0, 0), cB, voffB); PG8_STAGE(PG8_SB(0, 1), cB + hstep, voffB); PG8_STAGE(PG8_SA(0, 0), cA, voffA); PG8_STAGE(PG8_SA(0, 1), cA + hstep, voffA);
        if (wr == 1) PG8_BAR;
        PG8_WAIT_V(2); PG8_BAR;
        PG8_STAGE(PG8_SB(1, 0), cB + kstep, voffB); PG8_STAGE(PG8_SA(1, 0), cA + kstep, voffA); PG8_STAGE(PG8_SB(1, 1), cB + hstep + kstep, voffB);
        PG8_WAIT_V(6); PG8_BAR;
    } else {
        PG8_STAGE(PG8_SB(0, 0), cB, voffB); PG8_STAGE(PG8_SA(0, 0), cA, voffA); PG8_STAGE(PG8_SB(0, 1), cB + hstep, voffB); PG8_STAGE(PG8_SA(0, 1), cA + hstep, voffA);
        if (wr == 1) PG8_BAR;
        PG8_WAIT_V(4); PG8_BAR;
        PG8_STAGE(PG8_SB(1, 0), cB + kstep, voffB); PG8_STAGE(PG8_SA(1, 0), cA + kstep, voffA); PG8_STAGE(PG8_SB(1, 1), cB + hstep + kstep, voffB);
        PG8_WAIT_V(6); PG8_BAR;
    }
    for (;;) {
        const bool has_next = S.next(ui + 1, nxt);
        const char* nA = has_next ? (const char*)g.A + (size_t)nxt.pm * tstep : cA; const char* nB = has_next ? (const char*)g.Bt + (size_t)nxt.pn * tstep : cB;
        for (int t = 0; t < nt; t += 2) {
            const bool last = (t == nt - 2);
            const char* a1 = cA + (size_t)(t + 1) * kstep;
            const char* a2 = last ? nA : cA + (size_t)(t + 2) * kstep; const char* b2 = last ? nB : cB + (size_t)(t + 2) * kstep;
            const char* a3 = a2 + kstep; const char* b3 = b2 + kstep;
            if (last && has_next) S.a_ready(nxt);
            if constexpr (SP2) {
            PG8_LDB(B0, 0, 0); PG8_LDB(B1, 0, 1); PG8_SCHED; PG8_LDA(At, 0, 0); PG8_STAGE(PG8_SA(1, 1), a1 + hstep, voffA);
            PG8_WAIT_V(8); PG8_WAIT_L(0); PG8_BAR; PG8_MMA(0, 0, At, B0); PG8_MMA(0, 1, At, B1); PG8_BAR; PG8_SCHED;
            PG8_LDA(At, 0, 1); PG8_STAGE(PG8_SB(0, 0), b2, voffB); PG8_STAGE(PG8_SB(0, 1), b2 + hstep, voffB); PG8_STAGE(PG8_SA(0, 0), a2, voffA);
            PG8_WAIT_V(8); PG8_WAIT_L(0); PG8_BAR; PG8_MMA(1, 0, At, B0); PG8_MMA(1, 1, At, B1); PG8_BAR; PG8_SCHED;
            PG8_LDB(B0, 1, 0); PG8_LDB(B1, 1, 1); PG8_SCHED; PG8_LDA(At, 1, 0); PG8_STAGE(PG8_SA(0, 1), a2 + hstep, voffA);
            PG8_WAIT_V(8); PG8_WAIT_L(0); PG8_BAR; PG8_MMA(0, 0, At, B0); PG8_MMA(0, 1, At, B1); PG8_BAR; PG8_SCHED;
            PG8_LDA(At, 1, 1); PG8_STAGE(PG8_SB(1, 0), b3, voffB); PG8_STAGE(PG8_SB(1, 1), b3 + hstep, voffB); PG8_STAGE(PG8_SA(1, 0), a3, voffA);
            PG8_WAIT_V(8); PG8_WAIT_L(0); PG8_BAR; PG8_MMA(1, 0, At, B0); PG8_MMA(1, 1, At, B1); PG8_BAR; PG8_SCHED;
            } else {
            PG8_LDB(B0, 0, 0); PG8_SCHED; PG8_LDA(At, 0, 0); PG8_STAGE(PG8_SA(1, 1), a1 + hstep, voffA);
            PG8_WAIT_L(8); PG8_BAR; PG8_WAIT_L(0); PG8_MMA(0, 0, At, B0); PG8_BAR; PG8_SCHED;
            PG8_LDB(B1, 0, 1); PG8_STAGE(PG8_SB(0, 0), b2, voffB);
            PG8_BAR; PG8_WAIT_L(0); PG8_MMA(0, 1, At, B1); PG8_BAR;
            PG8_LDA(At, 0, 1); PG8_STAGE(PG8_SA(0, 0), a2, voffA);
            PG8_BAR; PG8_WAIT_L(0); PG8_MMA(1, 0, At, B0); PG8_BAR; PG8_SCHED;
            PG8_STAGE(PG8_SB(0, 1), b2 + hstep, voffB);
            PG8_WAIT_V(6); PG8_BAR; PG8_MMA(1, 1, At, B1); PG8_BAR;
            PG8_LDB(B0, 1, 0); PG8_SCHED; PG8_LDA(At, 1, 0); PG8_STAGE(PG8_SA(0, 1), a2 + hstep, voffA);
            PG8_WAIT_L(8); PG8_BAR; PG8_WAIT_L(0); PG8_MMA(0, 0, At, B0); PG8_BAR; PG8_SCHED;
            PG8_LDB(B1, 1, 1); PG8_STAGE(PG8_SB(1, 0), b3, voffB);
            PG8_BAR; PG8_WAIT_L(0); PG8_MMA(0, 1, At, B1); PG8_BAR;
            PG8_LDA(At, 1, 1); PG8_STAGE(PG8_SA(1, 0), a3, voffA);
            PG8_BAR; PG8_WAIT_L(0); PG8_MMA(1, 0, At, B0); PG8_BAR; PG8_SCHED;
            PG8_STAGE(PG8_SB(1, 1), b3 + hstep, voffB);
            PG8_WAIT_V(6); PG8_BAR; PG8_MMA(1, 1, At, B1); PG8_BAR;
            }
        }
        if constexpr (ALIGN_EPI) { if (wr == 0) PG8_BAR; }
        if constexpr (!Epi::AFTER_DRAIN) { E(acc, cur, wr, wc, fr, fq); S.done(cur); }
        if (!has_next) break;
#pragma unroll
        for (int a = 0; a < 2; ++a)
#pragma unroll
            for (int b = 0; b < 2; ++b)
#pragma unroll
                for (int m = 0; m < 4; ++m)
#pragma unroll
                    for (int n = 0; n < 2; ++n) acc[a][b][m][n] = (f32x4){0.f, 0.f, 0.f, 0.f};
        cur = nxt; cA = nA; cB = nB; ++ui;
        if constexpr (ALIGN_EPI) { if (wr == 1) PG8_BAR; }
    }
    PG8_WAIT_V(0);
    if constexpr (!ALIGN_EPI) { if (wr == 0) PG8_BAR; }
    PG8_BAR;
    if constexpr (Epi::AFTER_DRAIN) { E.fused(acc, cur, wr, wc, fr, fq, lds, wid, lane); S.done(cur); }
#undef PG8_SA
#undef PG8_SB
#undef PG8_STAGE
#undef PG8_LDA
#undef PG8_LDB
#undef PG8_MMA
#undef PG8_WAIT_V
#undef PG8_WAIT_L
#undef PG8_BAR
#undef PG8_SCHED
}
}

#define DI __device__ __forceinline__
typedef unsigned short bf16_t;
typedef float f32x4 __attribute__((ext_vector_type(4)));
typedef unsigned u32x4 __attribute__((ext_vector_type(4)));
typedef unsigned u32x2 __attribute__((ext_vector_type(2)));

constexpr int T_ALL = 17408, T_LAT = 16384, DM = 2048, NIN = 6416, NINP = 6656, DFF = 8192;
constexpr int HYO = 0, RWO = 1536, GDO = 3328, RGO = 5392;
constexpr int LDS_BYTES = 147456;
constexpr int NPH_LAYER = 11, NPH = 2 * NPH_LAYER + 1;

constexpr size_t al256(size_t x) { return (x + 255) & ~(size_t)255; }
constexpr size_t WS_MOD = 0;
constexpr size_t WS_PART = al256(WS_MOD + (size_t)5 * 12288 * 4);
constexpr size_t WS_HGL = al256(WS_PART + (size_t)32 * 5 * 12288 * 4);
constexpr size_t WS_HGC = al256(WS_HGL + (size_t)2 * 512 * 4096 * 4);
constexpr size_t WS_INORM = al256(WS_HGC + (size_t)2 * 512 * 256 * 4);
constexpr size_t WS_XC = al256(WS_INORM + 1024 * 4);
constexpr size_t WS_A = al256(WS_XC + (size_t)1024 * 2048 * 4);
constexpr size_t WS_PX = al256(WS_A + (size_t)T_ALL * 2048 * 2);
constexpr size_t WS_WO = al256(WS_PX + (size_t)T_ALL * NINP * 2);
constexpr size_t WS_W1 = al256(WS_WO + (size_t)2048 * 2048 * 2);
constexpr size_t WS_W2 = al256(WS_W1 + (size_t)8192 * 2048 * 2);
constexpr size_t WS_WIN = al256(WS_W2 + (size_t)2048 * 8192 * 2);
constexpr size_t WS_H = al256(WS_WIN + (size_t)NINP * 2048 * 2);
constexpr size_t WS_END = WS_H + (size_t)T_ALL * 8192 * 2;
constexpr size_t MSU = (size_t)T_ALL * 512 * 2;

struct Params { const float* in[43]; float* out; unsigned char* ws; };

DI float bf2f(bf16_t v) { return __uint_as_float((unsigned)v << 16); }
DI bf16_t f2bf(float f) { unsigned u = __float_as_uint(f); return (bf16_t)((u + 0x7fffu + ((u >> 16) & 1u)) >> 16); }
DI unsigned pk2(float lo, float hi) { return (unsigned)f2bf(lo) | ((unsigned)f2bf(hi) << 16); }
DI float bflo(unsigned w) { return __uint_as_float(w << 16); }
DI float bfhi(unsigned w) { return __uint_as_float(w & 0xffff0000u); }
DI float wave_sum(float v) {
#pragma unroll
    for (int o = 1; o < 64; o <<= 1) v += __shfl_xor(v, o);
    return v;
}
DI float sigm(float x) { return 1.f / (1.f + __expf(-x)); }
DI float siluf(float x) { return x / (1.f + __expf(-x)); }
DI float softplusf(float x) { return fmaxf(x, 0.f) + log1pf(__expf(-fabsf(x))); }
DI float gelu_tanh(float x) { return 0.5f * x * (1.f + tanhf(0.7978845608f * (x + 0.044715f * x * x * x))); }
#define LDSW() asm volatile("s_waitcnt lgkmcnt(0)" ::: "memory")

DI int scan_row(int n, int d, int b, bool& first) {
    if (n < 256) { const int tp = d ? 255 - n : n; first = (n == 0); return T_LAT + b * 256 + tp; }
    const int m = n - 256; const int tp = d ? 4095 - m : m; first = (m == 0); return b * 4096 + tp;
}

struct EpiStoreBf16 {
    static constexpr bool PERM = true, AFTER_DRAIN = false;
    bf16_t* O; int ldc; int act;
    DI void operator()(const pg8::f32x4 (&acc)[2][2][4][2], const pg8::Unit& u, int wr, int wc, int fr, int fq) const {
        const int row0 = u.pm * 256 + wr * 64 + fr, col0 = u.pn * 256 + wc * 32 + 8 * fq;
#pragma unroll
        for (int ai = 0; ai < 2; ++ai)
#pragma unroll
            for (int m = 0; m < 4; ++m) { bf16_t* rowp = O + (size_t)(row0 + ai * 128 + m * 16) * ldc + col0;
#pragma unroll
                for (int bj = 0; bj < 2; ++bj) { f32x4 v0 = acc[ai][bj][m][0], v1 = acc[ai][bj][m][1];
                    if (act) {
#pragma unroll
                        for (int e = 0; e < 4; ++e) { const float a = fmaxf(v0[e], 0.f), b = fmaxf(v1[e], 0.f); v0[e] = a * a; v1[e] = b * b; } }
                    u32x4 w; w.x = pg8::cvt_pk_bf16(v0[0], v0[1]); w.y = pg8::cvt_pk_bf16(v0[2], v0[3]); w.z = pg8::cvt_pk_bf16(v1[0], v1[1]); w.w = pg8::cvt_pk_bf16(v1[2], v1[3]);
                    *(u32x4*)(rowp + bj * 128) = w; } }
    }
};
struct EpiResidual {
    static constexpr bool PERM = false, AFTER_DRAIN = false;
    const float* baseL; const float* baseC; float* outL; float* outC; const float* gate;
    DI void operator()(const pg8::f32x4 (&acc)[2][2][4][2], const pg8::Unit& u, int wr, int wc, int fr, int fq) const {
        const bool isc = u.pm >= 64; const int bi = isc ? 4 : (u.pm >> 4);
        const int rloc = (isc ? (u.pm - 64) : u.pm) * 256 + wr * 64 + fr;
        const float* base = isc ? baseC : baseL; float* out = isc ? outC : outL;
        const int col0 = u.pn * 256 + wc * 32 + 4 * fq;
        const float* gp = gate + (size_t)bi * 12288 + col0;
        f32x4 g4[2][2];
#pragma unroll
        for (int bj = 0; bj < 2; ++bj)
#pragma unroll
            for (int n = 0; n < 2; ++n) g4[bj][n] = *(const f32x4*)(gp + bj * 128 + n * 16);
#pragma unroll
        for (int ai = 0; ai < 2; ++ai)
#pragma unroll
            for (int m = 0; m < 4; ++m) { const size_t off = (size_t)(rloc + ai * 128 + m * 16) * DM + col0;
#pragma unroll
                for (int bj = 0; bj < 2; ++bj)
#pragma unroll
                    for (int n = 0; n < 2; ++n) { const f32x4 bs = *(const f32x4*)(base + off + bj * 128 + n * 16);
                        *(f32x4*)(out + off + bj * 128 + n * 16) = bs + g4[bj][n] * acc[ai][bj][m][n]; }
                asm volatile("" ::: "memory"); }
    }
};

DI void tr_item(const float* W, int K, int N, int Npad, bf16_t* WT, float* scr, int item, int lane) {
    const int nblk = Npad / 32, kb = item / nblk, nb = item % nblk, k0 = 64 * kb, n0 = 32 * nb;
    const int n = n0 + (lane & 31);
#pragma unroll 8
    for (int i = 0; i < 32; ++i) { const int kk = 2 * i + (lane >> 5); scr[kk * 33 + (lane & 31)] = (n < N) ? W[(size_t)(k0 + kk) * N + n] : 0.f; }
    LDSW();
    const int c = lane & 7;
#pragma unroll
    for (int j = 0; j < 4; ++j) { const int nn = (lane >> 3) + 8 * j; const float* s = scr + (8 * c) * 33 + nn;
        u32x4 o; o.x = pk2(s[0 * 33], s[1 * 33]); o.y = pk2(s[2 * 33], s[3 * 33]); o.z = pk2(s[4 * 33], s[5 * 33]); o.w = pk2(s[6 * 33], s[7 * 33]);
        *(u32x4*)(WT + (size_t)(n0 + nn) * K + k0 + 8 * c) = o; }
    LDSW();
}

DI void ph_weights(const Params& p, int l, unsigned char* lds, int gw, int ngw, int wave, int lane) {
    float* scr = (float*)(lds + wave * 8448);
    const float* win = p.in[8] + (size_t)l * 2048 * NIN; const float* wo = p.in[9] + (size_t)l * 2048 * 2048;
    const float* w1 = p.in[40] + (size_t)l * 2048 * 8192; const float* w2 = p.in[41] + (size_t)l * 8192 * 2048;
    bf16_t* WinT = (bf16_t*)(p.ws + WS_WIN); bf16_t* WoT = (bf16_t*)(p.ws + WS_WO); bf16_t* W1T = (bf16_t*)(p.ws + WS_W1); bf16_t* W2T = (bf16_t*)(p.ws + WS_W2);
    constexpr int I_IN = 32 * (NINP / 32), I_O = 32 * 64, I_1 = 32 * 256, I_2 = 128 * 64;
    for (int it = gw; it < I_IN + I_O + I_1 + I_2; it += ngw) {
        int r = it;
        if (r < I_IN) { tr_item(win, 2048, NIN, NINP, WinT, scr, r, lane); continue; } r -= I_IN;
        if (r < I_O) { tr_item(wo, 2048, 2048, 2048, WoT, scr, r, lane); continue; } r -= I_O;
        if (r < I_1) { tr_item(w1, 2048, 8192, 8192, W1T, scr, r, lane); continue; } r -= I_1;
        tr_item(w2, 8192, 2048, 2048, W2T, scr, r, lane);
    }
}

DI void ph_ada_partial(const Params& p, int l, unsigned char* lds, int bid, int G, int tid) {
    float* sl = (float*)lds;
    const float* aw = p.in[4] + (size_t)l * 2048 * 12288;
    float* PART = (float*)(p.ws + WS_PART);
    for (int it = bid; it < 24 * 32; it += G) {
        const int cb = it % 24, kc = it / 24;
        __syncthreads();
        if (tid < 320) { const int i = tid >> 6, kk = tid & 63; const float c = i < 4 ? p.in[1][i * 2048 + kc * 64 + kk] : p.in[3][kc * 64 + kk]; sl[tid] = siluf(c); }
        __syncthreads();
        const int col = cb * 512 + tid; float acc[5] = {0.f, 0.f, 0.f, 0.f, 0.f};
        const float* wp = aw + (size_t)(kc * 64) * 12288 + col;
#pragma unroll 8
        for (int kk = 0; kk < 64; ++kk) { const float w = wp[(size_t)kk * 12288];
#pragma unroll
            for (int i = 0; i < 5; ++i) acc[i] += sl[i * 64 + kk] * w; }
#pragma unroll
        for (int i = 0; i < 5; ++i) PART[((size_t)kc * 5 + i) * 12288 + col] = acc[i];
    }
    __syncthreads();
}

DI void ph_hyfilt(const Params& p, int l, unsigned char* lds, int bid, int G, int tid) {
    float* feat = (float*)lds;
    float* h1 = feat + 16 * 33;
    float* h2T = h1 + 16 * 64;
    const float* w1 = p.in[11] + (size_t)l * 33 * 64; const float* b1 = p.in[12] + l * 64;
    const float* w2 = p.in[13] + (size_t)l * 64 * 64; const float* b2 = p.in[14] + l * 64;
    const float* w3 = p.in[15] + (size_t)l * 64 * 1024; const float* fq = p.in[16] + l * 128;
    const int nitems = (l == 0) ? 256 + 16 : 256;
    for (int it = bid; it < nitems; it += G) {
        const int L = it < 256 ? 4096 : 256; const int t0 = (it < 256 ? it : it - 256) * 16;
        float* HG = (float*)(p.ws + (it < 256 ? WS_HGL : WS_HGC));
        const float invLm1 = 1.f / (float)(L - 1);
        __syncthreads();
        for (int idx = tid; idx < 16 * 33; idx += 512) { const int tt = idx / 33, f = idx % 33; const float t = (float)(t0 + tt); float val;
            if (f == 0) val = t * invLm1;
            else { const int i = (f - 1) & 15; const float band = 1e-4f + (float)i * ((15.f - 1e-4f) / 15.f); const float ang = (6.283185307179586f / (float)L) * t * band; val = (f <= 16) ? cosf(ang) : -sinf(ang); }
            feat[idx] = val; }
        __syncthreads();
        for (int o = tid; o < 1024; o += 512) { const int tt = o >> 6, j = o & 63; float acc = 0.f;
            for (int f = 0; f < 33; ++f) acc += feat[tt * 33 + f] * w1[f * 64 + j];
            h1[tt * 64 + j] = sinf(fq[j] * (acc + b1[j])); }
        __syncthreads();
        for (int o = tid; o < 1024; o += 512) { const int tt = o >> 6, j = o & 63; float acc = 0.f;
            for (int i = 0; i < 64; ++i) acc += h1[tt * 64 + i] * w2[i * 64 + j];
            h2T[j * 16 + tt] = sinf(fq[64 + j] * (acc + b2[j])); }
        __syncthreads();
#pragma unroll 1
        for (int half = 0; half < 2; ++half) { const int col = tid + 512 * half; float acc[16];
#pragma unroll
            for (int tt = 0; tt < 16; ++tt) acc[tt] = 0.f;
            for (int i = 0; i < 64; ++i) { const float wv = w3[i * 1024 + col];
#pragma unroll
                for (int q = 0; q < 4; ++q) { const f32x4 hv = *(const f32x4*)(h2T + i * 16 + 4 * q); acc[4 * q] += hv[0] * wv; acc[4 * q + 1] += hv[1] * wv; acc[4 * q + 2] += hv[2] * wv; acc[4 * q + 3] += hv[3] * wv; } }
            const float delta = 3.0701134573253944f + (float)tid * (12.280453829301578f / 511.f);
            float* dst = HG + ((size_t)(half * 512 + tid)) * L + t0;
#pragma unroll
            for (int q = 0; q < 4; ++q) { f32x4 o;
#pragma unroll
                for (int e = 0; e < 4; ++e) { const float z = (float)(t0 + 4 * q + e) * invLm1; o[e] = acc[4 * q + e] * expf(-z * delta); }
                *(f32x4*)(dst + 4 * q) = o; } }
    }
    __syncthreads();
}

DI void ph_b(const Params& p, int l, int bid, int G, int tid, int gw, int ngw, int lane) {
    const float* PART = (const float*)(p.ws + WS_PART); float* MOD = (float*)(p.ws + WS_MOD);
    const float* ab = p.in[5] + (size_t)l * 12288;
    for (int idx = bid * 512 + tid; idx < 5 * 12288; idx += G * 512) { const int i = idx / 12288, col = idx % 12288; float s = ab[col];
        for (int kc = 0; kc < 32; ++kc) s += PART[((size_t)kc * 5 + i) * 12288 + col];
        MOD[idx] = s; }
    float* INORM = (float*)(p.ws + WS_INORM);
    const int nit = (l == 0) ? 1024 : 512;
    for (int it = gw; it < nit; it += ngw) { const int c = it & 511; const int L = it < 512 ? 4096 : 256;
        const float* HG = (const float*)(p.ws + (it < 512 ? WS_HGL : WS_HGC));
        const float* gf = HG + (size_t)c * L; const float* gb = HG + (size_t)(512 + c) * L; float s = 0.f;
        for (int t = lane; t < L; t += 64) s += fabsf(gf[t]) + (t > 0 ? fabsf(gb[t]) : 0.f);
        s = wave_sum(s);
        if (lane == 0) INORM[it] = 1.f / s; }
}

DI void ph_norm(const Params& p, const float* xl, const float* xc, const float* g, int sh_idx, int sc_idx, int M, int gw, int ngw, int lane) {
    const float* MOD = (const float*)(p.ws + WS_MOD); bf16_t* A = (bf16_t*)(p.ws + WS_A);
    for (int r = gw; r < M; r += ngw) {
        const float* src = r < T_LAT ? xl + (size_t)r * DM : xc + (size_t)(r - T_LAT) * DM;
        const int bi = r < T_LAT ? (r >> 12) : 4;
        const float* sh = MOD + (size_t)bi * 12288 + sh_idx * 2048; const float* sc = MOD + (size_t)bi * 12288 + sc_idx * 2048;
        f32x4 v[8]; float ss = 0.f;
#pragma unroll
        for (int j = 0; j < 8; ++j) { v[j] = *(const f32x4*)(src + 4 * lane + 256 * j); ss += (v[j][0] * v[j][0] + v[j][1] * v[j][1]) + (v[j][2] * v[j][2] + v[j][3] * v[j][3]); }
        ss = wave_sum(ss); const float rs = rsqrtf(ss * (1.f / 2048.f) + 1e-6f);
#pragma unroll
        for (int j = 0; j < 8; ++j) { const int c = 4 * lane + 256 * j; const f32x4 g4 = *(const f32x4*)(g + c), s4 = *(const f32x4*)(sc + c), h4 = *(const f32x4*)(sh + c);
            const f32x4 y = (v[j] * rs * g4) * (s4 + 1.f) + h4; u32x2 w; w.x = pk2(y[0], y[1]); w.y = pk2(y[2], y[3]);
            *(u32x2*)(A + (size_t)r * DM + c) = w; }
    }
}

DI void ph_rw_prep(const Params& p, int l, unsigned char* lds, int bid, int G, int tid) {
    float* xin = (float*)lds;
    const bf16_t* PX = (const bf16_t*)(p.ws + WS_PX);
    for (int it = bid; it < 2 * 1088; it += G) {
        const int d = it / 1088, tb = it % 1088; const int row0 = tb * 16;
        const float* mu = p.in[18] + (size_t)(l * 2 + d) * 1792 + 1536;
        __syncthreads();
#pragma unroll
        for (int i = 0; i < 8; ++i) { const int idx = tid + 512 * i; const int tok = idx >> 8, col = idx & 255; const int row = row0 + tok;
            const int t = row < T_LAT ? (row & 4095) : ((row - T_LAT) & 255); const int L = row < T_LAT ? 4096 : 256;
            const bool valid = d ? (t < L - 1) : (t > 0); const int pr = d ? row + 1 : row - 1;
            const float pv = bf2f(PX[(size_t)row * NINP + RWO + 1536 + col]); const float pp = valid ? bf2f(PX[(size_t)pr * NINP + RWO + 1536 + col]) : 0.f;
            const float pm = pv + (pp - pv) * mu[col];
            xin[col * 16 + tok] = col < 64 ? tanhf(pm) : (col < 128 ? pm : sigm(pm)); }
        __syncthreads();
        const int ch = tid;
        bf16_t* E = (bf16_t*)(p.ws + WS_H + (size_t)(0 + d) * MSU); bf16_t* AA = (bf16_t*)(p.ws + WS_H + (size_t)(2 + d) * MSU); bf16_t* GG = (bf16_t*)(p.ws + WS_H + (size_t)(4 + d) * MSU);
#pragma unroll 1
        for (int part = 0; part < 3; ++part) {
            const int j0 = part == 0 ? 0 : (part == 1 ? 64 : 128), nj = part == 2 ? 128 : 64;
            const float* up = part == 0 ? p.in[20] + (size_t)(l * 2 + d) * 64 * 512 : (part == 1 ? p.in[22] + (size_t)(l * 2 + d) * 64 * 512 : p.in[23] + (size_t)(l * 2 + d) * 128 * 512);
            float acc[16];
#pragma unroll
            for (int k = 0; k < 16; ++k) acc[k] = 0.f;
            for (int j = 0; j < nj; ++j) { const float wv = up[(size_t)j * 512 + ch]; const float* xr = xin + (j0 + j) * 16;
#pragma unroll
                for (int q = 0; q < 4; ++q) { const f32x4 xv = *(const f32x4*)(xr + 4 * q); acc[4 * q] += xv[0] * wv; acc[4 * q + 1] += xv[1] * wv; acc[4 * q + 2] += xv[2] * wv; acc[4 * q + 3] += xv[3] * wv; } }
            if (part == 0) { const float w0 = p.in[19][(l * 2 + d) * 512 + ch];
#pragma unroll
                for (int k = 0; k < 16; ++k) E[(size_t)(row0 + k) * 512 + ch] = f2bf(0.6065306597126334f * sigm(w0 + acc[k])); }
            else if (part == 1) { const float a0 = p.in[21][(l * 2 + d) * 512 + ch];
#pragma unroll
                for (int k = 0; k < 16; ++k) AA[(size_t)(row0 + k) * 512 + ch] = f2bf(sigm(a0 + acc[k])); }
            else {
#pragma unroll
                for (int k = 0; k < 16; ++k) GG[(size_t)(row0 + k) * 512 + ch] = f2bf(acc[k]); }
        }
    }
    __syncthreads();
}

DI void ph_gd_prep(const Params& p, int l, unsigned char* lds, int bid, int G, int tid, int lane, int wave) {
    unsigned* buf = (unsigned*)lds;
    bf16_t* PX = (bf16_t*)(p.ws + WS_PX);
    const float* cw = p.in[29] + (size_t)l * 4 * 1536;
    for (int it = bid; it < 3072 + 48; it += G) {
        int row0, NT, sl;
        if (it < 3072) { const int b = it / 768, rem = it % 768; row0 = b * 4096 + (rem / 12) * 64; sl = rem % 12; NT = 64; }
        else { const int ic = it - 3072; row0 = T_LAT + (ic / 12) * 256; sl = ic % 12; NT = 256; }
        const int col0 = GDO + sl * 128;
        __syncthreads();
        for (int idx = tid; idx < NT * 64; idx += 512) { const int tt = idx >> 6, c2 = idx & 63; buf[idx] = *(const unsigned*)(PX + (size_t)(row0 + tt) * NINP + col0 + 2 * c2); }
        __syncthreads();
        const int c = sl * 128 + 2 * lane;
        float w0[4], w1[4];
#pragma unroll
        for (int j = 0; j < 4; ++j) { w0[j] = cw[j * 1536 + c]; w1[j] = cw[j * 1536 + c + 1]; }
        for (int tt = wave; tt < NT; tt += 8) { float y0 = 0.f, y1 = 0.f;
#pragma unroll
            for (int j = 0; j < 4; ++j) { const int ts = tt - 2 + j; if (ts >= 0 && ts < NT) { const unsigned u = buf[ts * 64 + lane]; y0 += bflo(u) * w0[j]; y1 += bfhi(u) * w1[j]; } }
            y0 = siluf(y0); y1 = siluf(y1);
            if (sl < 8) { const float ss = wave_sum(y0 * y0 + y1 * y1); const float sc = rsqrtf(ss + 1e-6f) * (sl < 4 ? 0.08838834764831845f : 1.f); y0 *= sc; y1 *= sc; }
            *(unsigned*)(PX + (size_t)(row0 + tt) * NINP + col0 + 2 * lane) = pk2(y0, y1); }
    }
    __syncthreads();
}

DI void ph_rg_prep(const Params& p, int l, unsigned char* lds, int bid, int G, int tid) {
    float* xcT = (float*)lds;
    const bf16_t* PX = (const bf16_t*)(p.ws + WS_PX);
    const float* cw = p.in[33] + (size_t)l * 4 * 512; const float cb = p.in[34][l * 512 + tid];
    const int c = tid;
    for (int tb = bid; tb < 1088; tb += G) {
        const int row0 = tb * 16; const bool lat = row0 < T_LAT; const int t0 = lat ? (row0 & 4095) : ((row0 - T_LAT) & 255);
        float xown[16];
        __syncthreads();
#pragma unroll
        for (int k = 0; k < 16; ++k) { float a = cb; const int t = t0 + k;
#pragma unroll
            for (int j = 0; j < 4; ++j) { const int ts = t - 2 + j; const bool ok = lat ? ((ts >> 6) == (t >> 6) && ts >= 0) : (ts >= 0 && ts < 256);
                if (ok) a += cw[j * 512 + c] * bf2f(PX[(size_t)(row0 + k - 2 + j) * NINP + RGO + c]); }
            xown[k] = a; xcT[c * 16 + k] = a; }
        __syncthreads();
        const int n = c >> 7, jj = c & 127;
#pragma unroll 1
        for (int d = 0; d < 2; ++d) {
            const float* wa = p.in[35] + ((size_t)((l * 2 + d) * 4 + n) * 128) * 128 + jj; const float* wx = p.in[37] + ((size_t)((l * 2 + d) * 4 + n) * 128) * 128 + jj;
            float ar[16], ai[16];
#pragma unroll
            for (int k = 0; k < 16; ++k) { ar[k] = 0.f; ai[k] = 0.f; }
            for (int i = 0; i < 128; ++i) { const float wav = wa[(size_t)i * 128], wxv = wx[(size_t)i * 128]; const float* xr = xcT + (n * 128 + i) * 16;
#pragma unroll
                for (int q = 0; q < 4; ++q) { const f32x4 xv = *(const f32x4*)(xr + 4 * q);
#pragma unroll
                    for (int e = 0; e < 4; ++e) { ar[4 * q + e] += xv[e] * wav; ai[4 * q + e] += xv[e] * wxv; } } }
            const float ba = p.in[36][(l * 2 + d) * 512 + c], bx = p.in[38][(l * 2 + d) * 512 + c]; const float sp = softplusf(-p.in[39][(l * 2 + d) * 512 + c]);
            bf16_t* LA = (bf16_t*)(p.ws + WS_H + (size_t)(10 + d) * MSU); bf16_t* BB = (bf16_t*)(p.ws + WS_H + (size_t)(12 + d) * MSU);
#pragma unroll
            for (int k = 0; k < 16; ++k) { const float gr = sigm(ar[k] + ba), gi = sigm(ai[k] + bx); const float la = -8.f * gr * sp;
                const float bb = sqrtf(fmaxf(-expm1f(2.f * la), 0.f)) * (gi * xown[k]);
                LA[(size_t)(row0 + k) * 512 + c] = f2bf(la); BB[(size_t)(row0 + k) * 512 + c] = f2bf(bb); }
        }
    }
    __syncthreads();
}

DI void ph_hy_prep(const Params& p, int l, int bid, int G, int tid) {
    const bf16_t* PX = (const bf16_t*)(p.ws + WS_PX);
    bf16_t* ZT = (bf16_t*)(p.ws + WS_H + (size_t)14 * MSU); bf16_t* X0T = (bf16_t*)(p.ws + WS_H + (size_t)15 * MSU);
    const float* cw = p.in[10] + (size_t)l * 3 * 1536; const int c = tid;
    float wv[3], w0[3], w1[3];
#pragma unroll
    for (int j = 0; j < 3; ++j) { wv[j] = cw[j * 1536 + c]; w0[j] = cw[j * 1536 + 512 + c]; w1[j] = cw[j * 1536 + 1024 + c]; }
    const int nit = (l == 0) ? 256 + 16 : 256;
    for (int it = bid; it < nit; it += G) {
        int row0, L, t0, b; size_t zoff;
        if (it < 256) { b = it >> 6; t0 = (it & 63) * 64; L = 4096; row0 = b * 4096 + t0; zoff = ((size_t)b * 512 + c) * 4096 + t0; }
        else { const int ic = it - 256; b = ic >> 2; t0 = (ic & 3) * 64; L = 256; row0 = T_LAT + b * 256 + t0; zoff = (size_t)4 * 512 * 4096 + ((size_t)b * 512 + c) * 256 + t0; }
        const int rowlen = (it < 256) ? 64 : 256;
        const int tlo = (t0 / rowlen) * rowlen, thi = tlo + rowlen;
        float pv[3], p0[3], p1[3];
        { const bool ok = (t0 - 1) >= tlo; const bf16_t* q = PX + (size_t)(row0 - 1) * NINP + HYO + c;
          pv[0] = ok ? bf2f(q[0]) : 0.f; p0[0] = ok ? bf2f(q[512]) : 0.f; p1[0] = ok ? bf2f(q[1024]) : 0.f; }
        { const bf16_t* q = PX + (size_t)row0 * NINP + HYO + c; pv[1] = bf2f(q[0]); p0[1] = bf2f(q[512]); p1[1] = bf2f(q[1024]); }
#pragma unroll 1
        for (int k8 = 0; k8 < 8; ++k8) { unsigned zz[4], xx[4];
#pragma unroll
            for (int k = 0; k < 8; ++k) { const int tt = k8 * 8 + k; const bool ok = (t0 + tt + 1) < thi; const bf16_t* q = PX + (size_t)(row0 + tt + 1) * NINP + HYO + c;
                pv[2] = ok ? bf2f(q[0]) : 0.f; p0[2] = ok ? bf2f(q[512]) : 0.f; p1[2] = ok ? bf2f(q[1024]) : 0.f;
                const float v = pv[0] * wv[0] + pv[1] * wv[1] + pv[2] * wv[2], x0 = p0[0] * w0[0] + p0[1] * w0[1] + p0[2] * w0[2], x1 = p1[0] * w1[0] + p1[1] * w1[1] + p1[2] * w1[2];
                const unsigned zb = f2bf(x1 * v), xb = f2bf(x0);
                if (k & 1) { zz[k >> 1] |= zb << 16; xx[k >> 1] |= xb << 16; } else { zz[k >> 1] = zb; xx[k >> 1] = xb; }
                pv[0] = pv[1]; pv[1] = pv[2]; p0[0] = p0[1]; p0[1] = p0[2]; p1[0] = p1[1]; p1[1] = p1[2]; }
            u32x4 zo, xo; zo.x = zz[0]; zo.y = zz[1]; zo.z = zz[2]; zo.w = zz[3]; xo.x = xx[0]; xo.y = xx[1]; xo.z = xx[2]; xo.w = xx[3];
            *(u32x4*)(ZT + zoff + k8 * 8) = zo; *(u32x4*)(X0T + zoff + k8 * 8) = xo; }
        (void)L;
    }
}

DI void rw_scan(const Params& p, int l, int item, unsigned char* lds, int tid, int lane, int wave) {
    const int d = item >> 5, b = (item >> 3) & 3, h = item & 7;
    float* SB = (float*)lds;
    float* PT = (float*)(lds + 2 * 32 * 392 * 4);
    const bf16_t* PX = (const bf16_t*)(p.ws + WS_PX);
    const bf16_t* E = (const bf16_t*)(p.ws + WS_H + (size_t)(0 + d) * MSU); const bf16_t* AA = (const bf16_t*)(p.ws + WS_H + (size_t)(2 + d) * MSU);
    bf16_t* Y = (bf16_t*)(p.ws + WS_H + (size_t)(6 + d) * MSU);
    const int ch = h * 64 + lane;
    const float* mu = p.in[18] + (size_t)(l * 2 + d) * 1792;
    const float mur = mu[ch], muk = mu[512 + ch], muv = mu[1024 + ch];
    const float kkw = p.in[24][(l * 2 + d) * 512 + ch], kaw = p.in[25][(l * 2 + d) * 512 + ch];
    float S[8];
#pragma unroll
    for (int i = 0; i < 8; ++i) S[i] = 0.f;
    bf16_t gr[4], gk[4], gv[4], gpr[4], gpk[4], gpv[4], ge[4], ga[4];
#define RW_LOAD(blk) do { _Pragma("unroll") for (int j = 0; j < 4; ++j) { bool first; const int row = scan_row((blk) * 32 + wave * 4 + j, d, b, first); \
        const bf16_t* q = PX + (size_t)row * NINP + RWO + ch; gr[j] = q[0]; gk[j] = q[512]; gv[j] = q[1024]; \
        const bf16_t* qp = PX + (size_t)(first ? row : (d ? row + 1 : row - 1)) * NINP + RWO + ch; gpr[j] = first ? (bf16_t)0 : qp[0]; gpk[j] = first ? (bf16_t)0 : qp[512]; gpv[j] = first ? (bf16_t)0 : qp[1024]; \
        ge[j] = E[(size_t)row * 512 + ch]; ga[j] = AA[(size_t)row * 512 + ch]; } } while (0)
#define RW_WRITE(blk) do { float* sbn = SB + ((blk) & 1) * 32 * 392; _Pragma("unroll") for (int j = 0; j < 4; ++j) { float* st = sbn + (wave * 4 + j) * 392; \
        const float pr = bf2f(gr[j]), pk = bf2f(gk[j]), pv = bf2f(gv[j]); \
        const float r = pr + (bf2f(gpr[j]) - pr) * mur, k = pk + (bf2f(gpk[j]) - pk) * muk, v = pv + (bf2f(gpv[j]) - pv) * muv; \
        const float a = bf2f(ga[j]), w = __expf(-bf2f(ge[j])); const float kkr = k * kkw; const float n2 = wave_sum(kkr * kkr); \
        const float kk = kkr / fmaxf(sqrtf(n2), 1e-12f); const float kka = kk * a, kp = k * (1.f + (a - 1.f) * kaw); \
        const float c1 = wave_sum(kka * r), c2 = wave_sum(kp * r); \
        st[lane] = w; st[64 + lane] = kk; st[128 + lane] = kka; st[192 + lane] = kp; st[256 + lane] = w * r; st[320 + lane] = v; if (lane == 0) { st[384] = c1; st[385] = c2; } } } while (0)
    __syncthreads();
    RW_LOAD(0); RW_WRITE(0);
    __syncthreads();
    int pb = 0;
    for (int blk = 0; blk < 136; ++blk) {
        if (blk + 1 < 136) RW_LOAD(blk + 1);
        const float* sb = SB + (blk & 1) * 32 * 392;
        for (int s = 0; s < 32; ++s) {
            const float* st = sb + s * 392;
            const f32x4 kk0 = *(const f32x4*)(st + 64 + 8 * wave), kk1 = *(const f32x4*)(st + 68 + 8 * wave);
            const f32x4 wr0 = *(const f32x4*)(st + 256 + 8 * wave), wr1 = *(const f32x4*)(st + 260 + 8 * wave);
            float sk = (S[0] * kk0[0] + S[1] * kk0[1]) + (S[2] * kk0[2] + S[3] * kk0[3]) + (S[4] * kk1[0] + S[5] * kk1[1]) + (S[6] * kk1[2] + S[7] * kk1[3]);
            float yy = (S[0] * wr0[0] + S[1] * wr0[1]) + (S[2] * wr0[2] + S[3] * wr0[3]) + (S[4] * wr1[0] + S[5] * wr1[1]) + (S[6] * wr1[2] + S[7] * wr1[3]);
            float* pt = PT + pb * 1024;
            pt[wave * 64 + lane] = sk; pt[512 + wave * 64 + lane] = yy;
            __syncthreads();
            float skt = 0.f;
#pragma unroll
            for (int q = 0; q < 8; ++q) skt += pt[q * 64 + lane];
            const float vv = st[320 + lane];
            const f32x4 w0 = *(const f32x4*)(st + 8 * wave), w1 = *(const f32x4*)(st + 4 + 8 * wave);
            const f32x4 a0 = *(const f32x4*)(st + 128 + 8 * wave), a1 = *(const f32x4*)(st + 132 + 8 * wave);
            const f32x4 k0 = *(const f32x4*)(st + 192 + 8 * wave), k1 = *(const f32x4*)(st + 196 + 8 * wave);
#pragma unroll
            for (int i = 0; i < 4; ++i) { S[i] = S[i] * w0[i] + (vv * k0[i] - skt * a0[i]); S[4 + i] = S[4 + i] * w1[i] + (vv * k1[i] - skt * a1[i]); }
            if (wave == 0) { float yt = 0.f;
#pragma unroll
                for (int q = 0; q < 8; ++q) yt += pt[512 + q * 64 + lane];
                bool first; const int row = scan_row(blk * 32 + s, d, b, first);
                Y[(size_t)row * 512 + ch] = f2bf(yt - skt * st[384] + vv * st[385]); }
            pb ^= 1;
        }
        if (blk + 1 < 136) RW_WRITE(blk + 1);
        __syncthreads();
    }
#undef RW_LOAD
#undef RW_WRITE
}

DI void gd_scan(const Params& p, int l, int item, unsigned char* lds, int tid, int lane, int wave) {
    const int d = item >> 5, b = (item >> 3) & 3, h = (item >> 1) & 3, vh = item & 1;
    float* SB = (float*)lds;
    float* PT = (float*)(lds + 2 * 32 * 328 * 4);
    const bf16_t* PX = (const bf16_t*)(p.ws + WS_PX);
    bf16_t* O = (bf16_t*)(p.ws + WS_H + (size_t)(8 + d) * MSU);
    const float nA = -__expf(p.in[30][(l * 2 + d) * 4 + h]), dtb = p.in[31][(l * 2 + d) * 4 + h];
    float S[16];
#pragma unroll
    for (int i = 0; i < 16; ++i) S[i] = 0.f;
    unsigned gq[4], gk[4]; bf16_t gv[4], gg[4], gb[4];
#define GD_LOAD(blk) do { _Pragma("unroll") for (int j = 0; j < 4; ++j) { bool first; const int row = scan_row((blk) * 32 + wave * 4 + j, d, b, first); \
        const bf16_t* q = PX + (size_t)row * NINP + GDO; gq[j] = *(const unsigned*)(q + h * 128 + 2 * lane); gk[j] = *(const unsigned*)(q + 512 + h * 128 + 2 * lane); \
        gv[j] = q[1024 + h * 128 + vh * 64 + lane]; gg[j] = q[2048 + d * 4 + h]; gb[j] = q[2048 + (2 + d) * 4 + h]; } } while (0)
#define GD_WRITE(blk) do { float* sbn = SB + ((blk) & 1) * 32 * 328; _Pragma("unroll") for (int j = 0; j < 4; ++j) { float* st = sbn + (wave * 4 + j) * 328; \
        const float q0 = bflo(gq[j]), q1 = bfhi(gq[j]), k0 = bflo(gk[j]), k1 = bfhi(gk[j]); const float qk = wave_sum(q0 * k0 + q1 * k1); \
        st[2 * lane] = k0; st[2 * lane + 1] = k1; st[128 + 2 * lane] = q0; st[129 + 2 * lane] = q1; st[256 + lane] = bf2f(gv[j]); \
        if (lane == 0) { st[320] = __expf(nA * softplusf(bf2f(gg[j]) + dtb)); st[321] = sigm(bf2f(gb[j])); st[322] = qk; } } } while (0)
    __syncthreads();
    GD_LOAD(0); GD_WRITE(0);
    __syncthreads();
    int pb = 0;
    for (int blk = 0; blk < 136; ++blk) {
        if (blk + 1 < 136) GD_LOAD(blk + 1);
        const float* sb = SB + (blk & 1) * 32 * 328;
        for (int s = 0; s < 32; ++s) {
            const float* st = sb + s * 328;
            f32x4 kv[4], qv[4];
#pragma unroll
            for (int i = 0; i < 4; ++i) { kv[i] = *(const f32x4*)(st + 16 * wave + 4 * i); qv[i] = *(const f32x4*)(st + 128 + 16 * wave + 4 * i); }
            float pk = 0.f, pq = 0.f;
#pragma unroll
            for (int i = 0; i < 4; ++i)
#pragma unroll
                for (int e = 0; e < 4; ++e) { pk += S[4 * i + e] * kv[i][e]; pq += S[4 * i + e] * qv[i][e]; }
            float* pt = PT + pb * 1024;
            pt[wave * 64 + lane] = pk; pt[512 + wave * 64 + lane] = pq;
            __syncthreads();
            float kS = 0.f;
#pragma unroll
            for (int q = 0; q < 8; ++q) kS += pt[q * 64 + lane];
            const float alpha = st[320], beta = st[321];
            const float vnew = beta * (st[256 + lane] - alpha * kS);
#pragma unroll
            for (int i = 0; i < 4; ++i)
#pragma unroll
                for (int e = 0; e < 4; ++e) S[4 * i + e] = alpha * S[4 * i + e] + kv[i][e] * vnew;
            if (wave == 0) { float qS = 0.f;
#pragma unroll
                for (int q = 0; q < 8; ++q) qS += pt[512 + q * 64 + lane];
                bool first; const int row = scan_row(blk * 32 + s, d, b, first);
                O[(size_t)row * 512 + h * 128 + vh * 64 + lane] = f2bf(alpha * qS + st[322] * vnew); }
            pb ^= 1;
        }
        if (blk + 1 < 136) GD_WRITE(blk + 1);
        __syncthreads();
    }
#undef GD_LOAD
#undef GD_WRITE
}

DI void rg_scan(const Params& p, int item, int lane) {
    const int b = item >> 3, c = (item & 7) * 64 + lane;
    bf16_t* LA0 = (bf16_t*)(p.ws + WS_H + (size_t)10 * MSU); const bf16_t* LA1 = (const bf16_t*)(p.ws + WS_H + (size_t)11 * MSU);
    const bf16_t* B0 = (const bf16_t*)(p.ws + WS_H + (size_t)12 * MSU); const bf16_t* B1 = (const bf16_t*)(p.ws + WS_H + (size_t)13 * MSU);
    const bf16_t* PX = (const bf16_t*)(p.ws + WS_PX); bf16_t* CAT = (bf16_t*)(p.ws + WS_A);
    float h = 0.f;
#pragma unroll 8
    for (int n = 0; n < 4352; ++n) { bool first; const int row = scan_row(n, 0, b, first); const size_t o = (size_t)row * 512 + c;
        h = __expf(bf2f(LA0[o])) * h + bf2f(B0[o]); LA0[o] = f2bf(h); }
    h = 0.f;
#pragma unroll 8
    for (int n = 0; n < 4352; ++n) { bool first; const int row = scan_row(n, 1, b, first); const size_t o = (size_t)row * 512 + c;
        h = __expf(bf2f(LA1[o])) * h + bf2f(B1[o]);
        const float gt = bf2f(PX[(size_t)row * NINP + RGO + 512 + c]);
        CAT[(size_t)row * DM + 1536 + c] = f2bf(gelu_tanh(gt) * (bf2f(LA0[o]) + h)); }
}

template <int L>
DI void hy_conv(const Params& p, int l, int c, unsigned char* lds, int tid) {
    constexpr int NI = L >= 512 ? L / 512 : 1;
    float* zs = (float*)lds;
    float* gg = zs + L * 4;
    const bool isl = (L == 4096);
    bf16_t* ZT = (bf16_t*)(p.ws + WS_H + (size_t)14 * MSU) + (isl ? 0 : (size_t)4 * 512 * 4096);
    const bf16_t* X0T = (const bf16_t*)(p.ws + WS_H + (size_t)15 * MSU) + (isl ? 0 : (size_t)4 * 512 * 4096);
    const float* HG = (const float*)(p.ws + (isl ? WS_HGL : WS_HGC));
    const float inorm = ((const float*)(p.ws + WS_INORM))[(isl ? 0 : 512) + c];
    const float skip = p.in[17][l * 512 + c];
    __syncthreads();
    for (int idx = tid; idx < L * 4; idx += 512) { const int b = idx / L, t = idx % L; zs[t * 4 + b] = bf2f(ZT[((size_t)b * 512 + c) * L + t]); }
    for (int idx = tid; idx < 2 * L - 1; idx += 512) { const int dd = idx - (L - 1); gg[idx] = dd >= 0 ? HG[(size_t)c * L + dd] : HG[(size_t)(512 + c) * L - dd]; }
    __syncthreads();
    f32x4 acc[NI];
#pragma unroll
    for (int i = 0; i < NI; ++i) acc[i] = (f32x4){0.f, 0.f, 0.f, 0.f};
    const bool act = tid < L;
    if (act) {
        const float* gp = gg + (L - 1) + tid;
#pragma unroll 4
        for (int s = 0; s < L; ++s) { const f32x4 z4 = *(const f32x4*)(zs + 4 * s);
#pragma unroll
            for (int i = 0; i < NI; ++i) acc[i] += z4 * gp[512 * i - s]; }
#pragma unroll
        for (int i = 0; i < NI; ++i) { const int t = tid + 512 * i; const f32x4 z4 = *(const f32x4*)(zs + 4 * t);
#pragma unroll
            for (int b = 0; b < 4; ++b) { const size_t o = ((size_t)b * 512 + c) * L + t; const float y = acc[i][b] * inorm + z4[b] * skip; ZT[o] = f2bf(bf2f(X0T[o]) * y); } }
    }
    __syncthreads();
}

DI void ph_post(const Params& p, int l, unsigned char* lds, int gw, int ngw, int lane, int wave, int M) {
    const bf16_t* PX = (const bf16_t*)(p.ws + WS_PX); bf16_t* CAT = (bf16_t*)(p.ws + WS_A);
    const int ch = lane * 8;
    for (int row = gw; row < M; row += ngw) {
        float out[8];
#pragma unroll
        for (int e = 0; e < 8; ++e) out[e] = 0.f;
        const int t = row < T_LAT ? (row & 4095) : ((row - T_LAT) & 255); const int L = row < T_LAT ? 4096 : 256;
#pragma unroll 1
        for (int d = 0; d < 2; ++d) {
            const bool valid = d ? (t < L - 1) : (t > 0); const int pr = d ? row + 1 : row - 1;
            const float* mu = p.in[18] + (size_t)(l * 2 + d) * 1792; const int po = (l * 2 + d) * 512 + ch;
            const bf16_t* q = PX + (size_t)row * NINP + RWO + ch; const bf16_t* qp = PX + (size_t)(valid ? pr : row) * NINP + RWO + ch;
            const u32x4 ur = *(const u32x4*)q, uk = *(const u32x4*)(q + 512), uv = *(const u32x4*)(q + 1024);
            u32x4 pr4 = *(const u32x4*)qp, pk4 = *(const u32x4*)(qp + 512), pv4 = *(const u32x4*)(qp + 1024);
            const u32x4 ua = *(const u32x4*)((const bf16_t*)(p.ws + WS_H + (size_t)(2 + d) * MSU) + (size_t)row * 512 + ch);
            const u32x4 ug = *(const u32x4*)((const bf16_t*)(p.ws + WS_H + (size_t)(4 + d) * MSU) + (size_t)row * 512 + ch);
            const u32x4 uy = *(const u32x4*)((const bf16_t*)(p.ws + WS_H + (size_t)(6 + d) * MSU) + (size_t)row * 512 + ch);
            float r[8], k[8], v[8], a[8], g[8], y[8];
#pragma unroll
            for (int e = 0; e < 4; ++e) {
                const float r0 = bflo(ur[e]), r1 = bfhi(ur[e]), k0 = bflo(uk[e]), k1 = bfhi(uk[e]), v0 = bflo(uv[e]), v1 = bfhi(uv[e]);
                const float pr0 = valid ? bflo(pr4[e]) : 0.f, pr1 = valid ? bfhi(pr4[e]) : 0.f, pk0 = valid ? bflo(pk4[e]) : 0.f, pk1 = valid ? bfhi(pk4[e]) : 0.f, pv0 = valid ? bflo(pv4[e]) : 0.f, pv1 = valid ? bfhi(pv4[e]) : 0.f;
                r[2 * e] = r0 + (pr0 - r0) * mu[ch + 2 * e]; r[2 * e + 1] = r1 + (pr1 - r1) * mu[ch + 2 * e + 1];
                k[2 * e] = k0 + (pk0 - k0) * mu[512 + ch + 2 * e]; k[2 * e + 1] = k1 + (pk1 - k1) * mu[512 + ch + 2 * e + 1];
                v[2 * e] = v0 + (pv0 - v0) * mu[1024 + ch + 2 * e]; v[2 * e + 1] = v1 + (pv1 - v1) * mu[1024 + ch + 2 * e + 1];
                a[2 * e] = bflo(ua[e]); a[2 * e + 1] = bfhi(ua[e]); g[2 * e] = bflo(ug[e]); g[2 * e + 1] = bfhi(ug[e]); y[2 * e] = bflo(uy[e]); y[2 * e + 1] = bfhi(uy[e]); }
            float bs = 0.f, sy = 0.f;
#pragma unroll
            for (int e = 0; e < 8; ++e) { const float kp = k[e] * (1.f + (a[e] - 1.f) * p.in[25][po + e]); bs += r[e] * kp * p.in[26][po + e]; sy += y[e]; }
            bs += __shfl_xor(bs, 1); bs += __shfl_xor(bs, 2); bs += __shfl_xor(bs, 4);
            sy += __shfl_xor(sy, 1); sy += __shfl_xor(sy, 2); sy += __shfl_xor(sy, 4);
            const float mean = sy * (1.f / 64.f); float sv = 0.f;
#pragma unroll
            for (int e = 0; e < 8; ++e) { const float dd = y[e] - mean; sv += dd * dd; }
            sv += __shfl_xor(sv, 1); sv += __shfl_xor(sv, 2); sv += __shfl_xor(sv, 4);
            const float rstd = rsqrtf(sv * (1.f / 64.f) + 64e-5f);
#pragma unroll
            for (int e = 0; e < 8; ++e) out[e] += ((y[e] - mean) * rstd * p.in[27][po + e] + p.in[28][po + e] + bs * v[e]) * g[e];
        }
        { u32x4 w; w.x = pk2(out[0], out[1]); w.y = pk2(out[2], out[3]); w.z = pk2(out[4], out[5]); w.w = pk2(out[6], out[7]); *(u32x4*)(CAT + (size_t)row * DM + 512 + ch) = w; }
        { const u32x4 o0 = *(const u32x4*)((const bf16_t*)(p.ws + WS_H + (size_t)8 * MSU) + (size_t)row * 512 + ch);
          const u32x4 o1 = *(const u32x4*)((const bf16_t*)(p.ws + WS_H + (size_t)9 * MSU) + (size_t)row * 512 + ch);
          const u32x4 uz = *(const u32x4*)(PX + (size_t)row * NINP + GDO + 1536 + ch);
          float o[8], z[8]; float ss = 0.f;
#pragma unroll
          for (int e = 0; e < 4; ++e) { o[2 * e] = bflo(o0[e]) + bflo(o1[e]); o[2 * e + 1] = bfhi(o0[e]) + bfhi(o1[e]); z[2 * e] = bflo(uz[e]); z[2 * e + 1] = bfhi(uz[e]); }
#pragma unroll
          for (int e = 0; e < 8; ++e) ss += o[e] * o[e];
          ss += __shfl_xor(ss, 1); ss += __shfl_xor(ss, 2); ss += __shfl_xor(ss, 4); ss += __shfl_xor(ss, 8);
          const float rs = rsqrtf(ss * (1.f / 128.f) + 1e-6f);
#pragma unroll
          for (int e = 0; e < 8; ++e) o[e] = o[e] * rs * p.in[32][l * 128 + ((ch + e) & 127)] * siluf(z[e]);
          u32x4 w; w.x = pk2(o[0], o[1]); w.y = pk2(o[2], o[3]); w.z = pk2(o[4], o[5]); w.w = pk2(o[6], o[7]); *(u32x4*)(CAT + (size_t)row * DM + 1024 + ch) = w; }
    }
    bf16_t* tile = (bf16_t*)(lds + wave * (64 * 66 * 2));
    const bf16_t* OT = (const bf16_t*)(p.ws + WS_H + (size_t)14 * MSU);
    const int nit = (M > T_LAT) ? 2048 + 128 : 2048;
    for (int it = gw; it < nit; it += ngw) {
        int b, t0, c0, L, rowb; size_t base;
        if (it < 2048) { b = it >> 9; t0 = ((it >> 3) & 63) * 64; c0 = (it & 7) * 64; L = 4096; rowb = b * 4096; base = 0; }
        else { const int ic = it - 2048; b = ic >> 5; t0 = ((ic >> 3) & 3) * 64; c0 = (ic & 7) * 64; L = 256; rowb = T_LAT + b * 256; base = (size_t)4 * 512 * 4096; }
        for (int i = 0; i < 64; ++i) tile[i * 66 + lane] = OT[base + ((size_t)b * 512 + c0 + i) * L + t0 + lane];
        LDSW();
        for (int j = 0; j < 64; ++j) CAT[(size_t)(rowb + t0 + j) * DM + c0 + lane] = tile[lane * 66 + j];
        LDSW();
    }
}

DI void ph_final(const Params& p, int gw, int ngw, int lane) {
    const float* g = p.in[42];
    for (int r = gw; r < T_LAT; r += ngw) { float* src = p.out + (size_t)r * DM; f32x4 v[8]; float ss = 0.f;
#pragma unroll
        for (int j = 0; j < 8; ++j) { v[j] = *(const f32x4*)(src + 4 * lane + 256 * j); ss += (v[j][0] * v[j][0] + v[j][1] * v[j][1]) + (v[j][2] * v[j][2] + v[j][3] * v[j][3]); }
        ss = wave_sum(ss); const float rs = rsqrtf(ss * (1.f / 2048.f) + 1e-6f);
#pragma unroll
        for (int j = 0; j < 8; ++j) { const int c = 4 * lane + 256 * j; *(f32x4*)(src + c) = v[j] * rs * *(const f32x4*)(g + c); } }
}

template <int K>
DI void run_phase(const Params& p, const int l, unsigned char* lds) {
    const int tid = threadIdx.x, lane = tid & 63, wave = __builtin_amdgcn_readfirstlane(tid >> 6);
    const int G = gridDim.x, bid = blockIdx.x, gw = bid * 8 + wave, ngw = G * 8;
    const bool last = (l == 1);
    const int M = last ? T_LAT : T_ALL;
    const float* xl = l == 0 ? p.in[0] : p.out; const float* xc = l == 0 ? p.in[2] : (const float*)(p.ws + WS_XC);
    float* XC = (float*)(p.ws + WS_XC); const float* MOD = (const float*)(p.ws + WS_MOD);
    if constexpr (K == 0) { ph_weights(p, l, lds, gw, ngw, wave, lane); __syncthreads(); ph_ada_partial(p, l, lds, bid, G, tid); ph_hyfilt(p, l, lds, bid, G, tid); }
    else if constexpr (K == 1) { ph_b(p, l, bid, G, tid, gw, ngw, lane); }
    else if constexpr (K == 2) { ph_norm(p, xl, xc, p.in[6] + l * 2048, 0, 1, T_ALL, gw, ngw, lane); }
    else if constexpr (K == 3) {
        pg8::Gemm g{(const bf16_t*)(p.ws + WS_A), (const bf16_t*)(p.ws + WS_WIN), T_ALL, NINP, DM}; pg8::StaticOrder S; S.init(T_ALL, NINP, G, bid);
        EpiStoreBf16 E{(bf16_t*)(p.ws + WS_PX), NINP, 0};
        pg8::gemm_phase<EpiStoreBf16, pg8::StaticOrder, true, true>((PG8_LAS unsigned char*)lds, g, S, E);
    }
    else if constexpr (K == 4) { ph_rw_prep(p, l, lds, bid, G, tid); ph_gd_prep(p, l, lds, bid, G, tid, lane, wave); ph_rg_prep(p, l, lds, bid, G, tid); ph_hy_prep(p, l, bid, G, tid); }
    else if constexpr (K == 5) {
        if (bid < 64) rw_scan(p, l, bid, lds, tid, lane, wave);
        else if (bid < 128) gd_scan(p, l, bid - 64, lds, tid, lane, wave);
        else {
            const int hb = bid - 128, nhb = G - 128;
            if (hb < 4) rg_scan(p, hb * 8 + wave, lane);
            for (int c = hb; c < 512; c += nhb) hy_conv<4096>(p, l, c, lds, tid);
            if (l == 0) for (int c = hb; c < 512; c += nhb) hy_conv<256>(p, l, c, lds, tid);
        }
    }
    else if constexpr (K == 6) { ph_post(p, l, lds, gw, ngw, lane, wave, M); }
    else if constexpr (K == 7) {
        pg8::Gemm g{(const bf16_t*)(p.ws + WS_A), (const bf16_t*)(p.ws + WS_WO), M, DM, DM}; pg8::StaticOrder S; S.init(M, DM, G, bid);
        EpiResidual E{xl, xc, p.out, XC, MOD + 2 * 2048};
        pg8::gemm_phase<EpiResidual, pg8::StaticOrder, true, true>((PG8_LAS unsigned char*)lds, g, S, E);
    }
    else if constexpr (K == 8) { ph_norm(p, p.out, XC, p.in[7] + l * 2048, 3, 4, M, gw, ngw, lane); }
    else if constexpr (K == 9) {
        pg8::Gemm g{(const bf16_t*)(p.ws + WS_A), (const bf16_t*)(p.ws + WS_W1), M, DFF, DM}; pg8::StaticOrder S; S.init(M, DFF, G, bid);
        EpiStoreBf16 E{(bf16_t*)(p.ws + WS_H), DFF, 1};
        pg8::gemm_phase<EpiStoreBf16, pg8::StaticOrder, true, true>((PG8_LAS unsigned char*)lds, g, S, E);
    }
    else if constexpr (K == 10) {
        pg8::Gemm g{(const bf16_t*)(p.ws + WS_H), (const bf16_t*)(p.ws + WS_W2), M, DM, DFF}; pg8::StaticOrder S; S.init(M, DM, G, bid);
        EpiResidual E{p.out, XC, p.out, XC, MOD + 5 * 2048};
        pg8::gemm_phase<EpiResidual, pg8::StaticOrder, true, true>((PG8_LAS unsigned char*)lds, g, S, E);
    }
    else { ph_final(p, gw, ngw, lane); }
}

#ifndef MK_FUSED
#define MK_FUSED 0
#endif
#if MK_FUSED
__global__ void __launch_bounds__(512) mk_fwd(Params p) {
    extern __shared__ __attribute__((aligned(16))) unsigned char lds[];
    cg::grid_group grid = cg::this_grid();
#define PHS(K, L) run_phase<K>(p, L, lds); grid.sync();
#define LAYER(L) PHS(0, L) PHS(1, L) PHS(2, L) PHS(3, L) PHS(4, L) PHS(5, L) PHS(6, L) PHS(7, L) PHS(8, L) PHS(9, L) PHS(10, L)
    LAYER(0) LAYER(1)
    run_phase<11>(p, 1, lds);
}
#else
template <int K> __global__ void __launch_bounds__(512) k_phase(Params p, int l) {
    extern __shared__ __attribute__((aligned(16))) unsigned char lds[];
    run_phase<K>(p, l, lds);
}
template <int K> static void launch_phase(const Params& p, int l, int grid, hipStream_t stream) {
    static bool attr = false;
    if (!attr) { (void)hipFuncSetAttribute((const void*)k_phase<K>, hipFuncAttributeMaxDynamicSharedMemorySize, LDS_BYTES); attr = true; }
    hipLaunchKernelGGL(k_phase<K>, dim3(grid), dim3(512), LDS_BYTES, stream, p, l);
}
#endif

extern "C" void kernel_launch(void* const* d_in, const int* in_sizes, int n_in, void* d_out, int out_size, void* d_ws, size_t ws_size, hipStream_t stream) {
    static int grid_blocks = 0;
    if (grid_blocks == 0) {
        if (n_in != 43 || ws_size < WS_END) { fprintf(stderr, "kernel_launch: unexpected inputs (n_in %d, ws %zu < %zu)\n", n_in, ws_size, (size_t)WS_END); grid_blocks = -1; return; }
        int dev = 0, cus = 0, per_cu = 1;
        (void)hipGetDevice(&dev); (void)hipDeviceGetAttribute(&cus, hipDeviceAttributeMultiprocessorCount, dev);
#if MK_FUSED
        (void)hipFuncSetAttribute((const void*)mk_fwd, hipFuncAttributeMaxDynamicSharedMemorySize, LDS_BYTES);
        (void)hipOccupancyMaxActiveBlocksPerMultiprocessor(&per_cu, (const void*)mk_fwd, 512, LDS_BYTES);
        if (per_cu < 1) per_cu = 1;
#endif
        grid_blocks = cus * per_cu;
    }
    if (grid_blocks < 0) return;
    Params p{};
    for (int i = 0; i < 43; ++i) p.in[i] = (const float*)d_in[i];
    p.out = (float*)d_out; p.ws = (unsigned char*)d_ws;
#if MK_FUSED
    void* args[] = {&p};
    hipError_t e = hipLaunchCooperativeKernel((const void*)mk_fwd, dim3(grid_blocks), dim3(512), args, LDS_BYTES, stream);
    if (e != hipSuccess) fprintf(stderr, "cooperative launch failed: %s (grid %d)\n", hipGetErrorString(e), grid_blocks);
#else
    for (int l = 0; l < 2; ++l) {
        launch_phase<0>(p, l, grid_blocks, stream); launch_phase<1>(p, l, grid_blocks, stream); launch_phase<2>(p, l, grid_blocks, stream); launch_phase<3>(p, l, grid_blocks, stream);
        launch_phase<4>(p, l, grid_blocks, stream); launch_phase<5>(p, l, grid_blocks, stream); launch_phase<6>(p, l, grid_blocks, stream); launch_phase<7>(p, l, grid_blocks, stream);
        launch_phase<8>(p, l, grid_blocks, stream); launch_phase<9>(p, l, grid_blocks, stream); launch_phase<10>(p, l, grid_blocks, stream);
    }
    launch_phase<11>(p, 1, grid_blocks, stream);
#endif
}
```

```cpp
#include <hip/hip_runtime.h>
#include <hip/hip_cooperative_groups.h>
#include <cstdio>
#include <cstdint>
namespace cg = cooperative_groups;
namespace pg8 {
#define PG8_LAS __attribute__((address_space(3)))
typedef unsigned short bf16_t;
typedef short bf16x8 __attribute__((ext_vector_type(8)));
typedef float f32x4 __attribute__((ext_vector_type(4)));
typedef unsigned u32x4 __attribute__((ext_vector_type(4)));
constexpr int BM = 256, BK = 64, HALF = 128, HTB = HALF * BK * 2  , STAGE_BYTES = 8 * HTB, NXCD = 8, WGM = 8;

__host__ __device__ __forceinline__ int lds_byte(int r, int c) { const int st = (r >> 4) * 2 + (c >> 5), rr = r & 15, cc = c & 31, ob = rr * 64 + cc * 2; return st * 1024 + (ob ^ (((ob >> 9) & 1) << 5)); }
__host__ __device__ __forceinline__ void stage_rc(int b, int& R, int& C) { const int st = b / 1024, sb = b % 1024, swz = sb ^ (((sb >> 9) & 1) << 5); R = (st >> 1) * 16 + swz / 64; C = (st & 1) * 32 + (swz % 64) / 2; }
__host__ __device__ __forceinline__ int perm32(int rho) { const int n = rho >> 4, i = rho & 15; return 8 * (i >> 2) + 4 * n + (i & 3); }

struct Unit { int pm, pn; };
struct Gemm { const bf16_t* A; const bf16_t* Bt; int M, N, K, ld; };

struct StaticOrder {
    int nM, nN, nwg, G, c;
    __host__ __device__ void init(int M, int N, int G_, int c_) { nM = M / BM; nN = N / BM; nwg = nM * nN; G = G_; c = c_; }
    __host__ __device__ bool next(int i, Unit& u) const {
        const long L = (long)i * G + c; if (L >= nwg) return false;
        int wgid = (int)L; { const int q = nwg / NXCD, r = nwg % NXCD, xcd = wgid % NXCD, off = wgid / NXCD; wgid = (xcd < r ? xcd * (q + 1) : r * (q + 1) + (xcd - r) * q) + off; }
        const int nig = WGM * nN, gid = wgid / nig, fm = gid * WGM, gsz = (nM - fm) < WGM ? (nM - fm) : WGM;
        u.pm = fm + ((wgid % nig) % gsz); u.pn = (wgid % nig) / gsz; return true;
    }
    __device__ __forceinline__ void a_ready(const Unit&) const {}
    __device__ __forceinline__ void done(const Unit&) const {}
};

__device__ __forceinline__ unsigned cvt_pk_bf16(float lo, float hi) { unsigned r; asm volatile("v_cvt_pk_bf16_f32 %0, %1, %2" : "=v"(r) : "v"(lo), "v"(hi)); return r; }
typedef float f32x2 __attribute__((ext_vector_type(2)));
template <class Epi, class Sched, bool ALIGN_EPI = false, bool SP2 = false>
__device__ __forceinline__ void gemm_phase(PG8_LAS unsigned char* lds, const Gemm g, const Sched& S, const Epi& E, const int tid) {
    const int wid = __builtin_amdgcn_readfirstlane(tid >> 6), lane = tid & 63, wr = wid >> 2, wc = wid & 3, fr = lane & 15, fq = lane >> 4;
    const int nt = g.K / BK; const int K = g.ld ? g.ld : g.K;
    unsigned voffA[2], voffB[2];
#pragma unroll
    for (int i = 0; i < 2; ++i) { int R, C; stage_rc(tid * 16 + i * 8192, R, C); const int Rb = Epi::PERM ? ((R & ~31) + perm32(R & 31)) : R;
        voffA[i] = (unsigned)(R * K + C) * 2u; voffB[i] = (unsigned)(Rb * K + C) * 2u; }
    const size_t kstep = (size_t)(BK * 2);
    const size_t hstep = (size_t)HALF * K * 2;
    const size_t tstep = 2 * hstep;
    const unsigned ldsw = (unsigned)wid * 1024u;
    const int aoff = lds_byte(wr * 64 + fr, fq * 8), boff = lds_byte(wc * 32 + fr, fq * 8);
#define PG8_SA(b, h) (((b) * 2 + (h)) * HTB)
#define PG8_SB(b, h) ((4 + (b) * 2 + (h)) * HTB)
#define PG8_STAGE(bufoff, gbase, voff) do { _Pragma("unroll") for (int _i = 0; _i < 2; ++_i) \
        __builtin_amdgcn_global_load_lds((const unsigned*)((const char*)(gbase) + (voff)[_i]), (PG8_LAS unsigned*)(lds + (bufoff) + ldsw + _i * 8192), 16, 0, 0); } while (0)
#define PG8_LDA(dst, b, h) do { _Pragma("unroll") for (int m = 0; m < 4; ++m) _Pragma("unroll") for (int k = 0; k < 2; ++k) dst[m][k] = *(const PG8_LAS bf16x8*)(lds + PG8_SA(b, h) + aoff + m * 2048 + k * 1024); } while (0)
#define PG8_LDB(dst, b, h) do { _Pragma("unroll") for (int n = 0; n < 2; ++n) _Pragma("unroll") for (int k = 0; k < 2; ++k) dst[n][k] = *(const PG8_LAS bf16x8*)(lds + PG8_SB(b, h) + boff + n * 2048 + k * 1024); } while (0)
#define PG8_MMA(ai, bj, At, Bt) do { __builtin_amdgcn_s_setprio(1); _Pragma("unroll") for (int m = 0; m < 4; ++m) _Pragma("unroll") for (int n = 0; n < 2; ++n) _Pragma("unroll") for (int k = 0; k < 2; ++k) \
        acc[ai][bj][m][n] = __builtin_amdgcn_mfma_f32_16x16x32_bf16(Bt[n][k], At[m][k], acc[ai][bj][m][n], 0, 0, 0); __builtin_amdgcn_s_setprio(0); } while (0)
#define PG8_WAIT_V(n) asm volatile("s_waitcnt vmcnt(" #n ")" ::: "memory")
#define PG8_WAIT_L(n) asm volatile("s_waitcnt lgkmcnt(" #n ")" ::: "memory")
#define PG8_BAR __builtin_amdgcn_s_barrier()
#define PG8_SCHED __builtin_amdgcn_sched_barrier(0)
    Unit cur, nxt; int ui = 0;
    if (!S.next(0, cur)) return;
    f32x4 acc[2][2][4][2];
#pragma unroll
    for (int a = 0; a < 2; ++a)
#pragma unroll
        for (int b = 0; b < 2; ++b)
#pragma unroll
            for (int m = 0; m < 4; ++m)
#pragma unroll
                for (int n = 0; n < 2; ++n) acc[a][b][m][n] = (f32x4){0.f, 0.f, 0.f, 0.f};
    bf16x8 At[4][2], B0[2][2], B1[2][2];
    const char* cA = (const char*)g.A + (size_t)cur.pm * tstep; const char* cB = (const char*)g.Bt + (size_t)cur.pn * tstep;
    S.a_ready(cur);
    if constexpr (SP2) {
        PG8_STAGE(PG8_SB(0, 0), cB, voffB); PG8_STAGE(PG8_SB(0, 1), cB + hstep, voffB); PG8_STAGE(PG8_SA(0, 0), cA, voffA); PG8_STAGE(PG8_SA(0, 1), cA + hstep, voffA);
        if (wr == 1) PG8_BAR;
        PG8_WAIT_V(2); PG8_BAR;
        PG8_STAGE(PG8_SB(1, 0), cB + kstep, voffB); PG8_STAGE(PG8_SA(1, 0), cA + kstep, voffA); PG8_STAGE(PG8_SB(1, 1), cB + hstep + kstep, voffB);
        PG8_WAIT_V(6); PG8_BAR;
    } else {
        PG8_STAGE(PG8_SB(0, 0), cB, voffB); PG8_STAGE(PG8_SA(0, 0), cA, voffA); PG8_STAGE(PG8_SB(0, 1), cB + hstep, voffB); PG8_STAGE(PG8_SA(0, 1), cA + hstep, voffA);
        if (wr == 1) PG8_BAR;
        PG8_WAIT_V(4); PG8_BAR;
        PG8_STAGE(PG8_SB(1, 0), cB + kstep, voffB); PG8_STAGE(PG8_SA(1, 0), cA + kstep, voffA); PG8_STAGE(PG8_SB(1, 1), cB + hstep + kstep, voffB);
        PG8_WAIT_V(6); PG8_BAR;
    }
    for (;;) {
        const bool has_next = S.next(ui + 1, nxt);
        const char* nA = has_next ? (const char*)g.A + (size_t)nxt.pm * tstep : cA; const char* nB = has_next ? (const char*)g.Bt + (size_t)nxt.pn * tstep : cB;
        for (int t = 0; t < nt; t += 2) {
            const bool last = (t == nt - 2);
            const char* a1 = cA + (size_t)(t + 1) * kstep;
            const char* a2 = last ? nA : cA + (size_t)(t + 2) * kstep; const char* b2 = last ? nB : cB + (size_t)(t + 2) * kstep;
            const char* a3 = a2 + kstep; const char* b3 = b2 + kstep;
            if (last && has_next) S.a_ready(nxt);
            if constexpr (SP2) {
            PG8_LDB(B0, 0, 0); PG8_LDB(B1, 0, 1); PG8_SCHED; PG8_LDA(At, 0, 0); PG8_STAGE(PG8_SA(1, 1), a1 + hstep, voffA);
            PG8_WAIT_V(8); PG8_WAIT_L(0); PG8_BAR; PG8_MMA(0, 0, At, B0); PG8_MMA(0, 1, At, B1); PG8_BAR; PG8_SCHED;
            PG8_LDA(At, 0, 1); PG8_STAGE(PG8_SB(0, 0), b2, voffB); PG8_STAGE(PG8_SB(0, 1), b2 + hstep, voffB); PG8_STAGE(PG8_SA(0, 0), a2, voffA);
            PG8_WAIT_V(8); PG8_WAIT_L(0); PG8_BAR; PG8_MMA(1, 0, At, B0); PG8_MMA(1, 1, At, B1); PG8_BAR; PG8_SCHED;
            PG8_LDB(B0, 1, 0); PG8_LDB(B1, 1, 1); PG8_SCHED; PG8_LDA(At, 1, 0); PG8_STAGE(PG8_SA(0, 1), a2 + hstep, voffA);
            PG8_WAIT_V(8); PG8_WAIT_L(0); PG8_BAR; PG8_MMA(0, 0, At, B0); PG8_MMA(0, 1, At, B1); PG8_BAR; PG8_SCHED;
            PG8_LDA(At, 1, 1); PG8_STAGE(PG8_SB(1, 0), b3, voffB); PG8_STAGE(PG8_SB(1, 1), b3 + hstep, voffB); PG8_STAGE(PG8_SA(1, 0), a3, voffA);
            PG8_WAIT_V(8); PG8_WAIT_L(0); PG8_BAR; PG8_MMA(1, 0, At, B0); PG8_MMA(1, 1, At, B1); PG8_BAR; PG8_SCHED;
            } else {
            PG8_LDB(B0, 0, 0); PG8_SCHED; PG8_LDA(At, 0, 0); PG8_STAGE(PG8_SA(1, 1), a1 + hstep, voffA);
            PG8_WAIT_L(8); PG8_BAR; PG8_WAIT_L(0); PG8_MMA(0, 0, At, B0); PG8_BAR; PG8_SCHED;
            PG8_LDB(B1, 0, 1); PG8_STAGE(PG8_SB(0, 0), b2, voffB);
            PG8_BAR; PG8_WAIT_L(0); PG8_MMA(0, 1, At, B1); PG8_BAR;
            PG8_LDA(At, 0, 1); PG8_STAGE(PG8_SA(0, 0), a2, voffA);
            PG8_BAR; PG8_WAIT_L(0); PG8_MMA(1, 0, At, B0); PG8_BAR; PG8_SCHED;
            PG8_STAGE(PG8_SB(0, 1), b2 + hstep, voffB);
            PG8_WAIT_V(6); PG8_BAR; PG8_MMA(1, 1, At, B1); PG8_BAR;
            PG8_LDB(B0, 1, 0); PG8_SCHED; PG8_LDA(At, 1, 0); PG8_STAGE(PG8_SA(0, 1), a2 + hstep, voffA);
            PG8_WAIT_L(8); PG8_BAR; PG8_WAIT_L(0); PG8_MMA(0, 0, At, B0); PG8_BAR; PG8_SCHED;
            PG8_LDB(B1, 1, 1); PG8_STAGE(PG8_SB(1, 0), b3, voffB);
            PG8_BAR; PG8_WAIT_L(0); PG8_MMA(0, 1, At, B1); PG8_BAR;
            PG8_LDA(At, 1, 1); PG8_STAGE(PG8_SA(1, 0), a3, voffA);
            PG8_BAR; PG8_WAIT_L(0); PG8_MMA(1, 0, At, B0); PG8_BAR; PG8_SCHED;
            PG8_STAGE(PG8_SB(1, 1), b3 + hstep, voffB);
            PG8_WAIT_V(6); PG8_BAR; PG8_MMA(1, 1, At, B1); PG8_BAR;
            }
        }
        if constexpr (ALIGN_EPI) { if (wr == 0) PG8_BAR; }
        if constexpr (!Epi::AFTER_DRAIN) { E(acc, cur, wr, wc, fr, fq); S.done(cur); }
        if (!has_next) break;
#pragma unroll
        for (int a = 0; a < 2; ++a)
#pragma unroll
            for (int b = 0; b < 2; ++b)
#pragma unroll
                for (int m = 0; m < 4; ++m)
#pragma unroll
                    for (int n = 0; n < 2; ++n) acc[a][b][m][n] = (f32x4){0.f, 0.f, 0.f, 0.f};
        cur = nxt; cA = nA; cB = nB; ++ui;
        if constexpr (ALIGN_EPI) { if (wr == 1) PG8_BAR; }
    }
    PG8_WAIT_V(0);
    if constexpr (!ALIGN_EPI) { if (wr == 0) PG8_BAR; }
    PG8_BAR;
    if constexpr (Epi::AFTER_DRAIN) { E.fused(acc, cur, wr, wc, fr, fq, lds, wid, lane); S.done(cur); }
#undef PG8_SA
#undef PG8_SB
#undef PG8_STAGE
#undef PG8_LDA
#undef PG8_LDB
#undef PG8_MMA
#undef PG8_WAIT_V
#undef PG8_WAIT_L
#undef PG8_BAR
#undef PG8_SCHED
}
}

#define DI __device__ __forceinline__
typedef unsigned short bf16_t;
typedef float f32x4 __attribute__((ext_vector_type(4)));
typedef unsigned u32x4 __attribute__((ext_vector_type(4)));
typedef unsigned u32x2 __attribute__((ext_vector_type(2)));

constexpr int T_ALL = 17408, T_LAT = 16384, DM = 2048, NIN = 6416, NINP = 6656, DFF = 8192;
constexpr int HYO = 0, RWO = 1536, GDO = 3328, RGO = 5392;
constexpr int LDS_BYTES = 147456;
constexpr int NPH_LAYER = 11, NPH = 2 * NPH_LAYER + 1;

constexpr size_t al256(size_t x) { return (x + 255) & ~(size_t)255; }
constexpr size_t WS_MOD = 0;
constexpr size_t WS_PART = al256(WS_MOD + (size_t)5 * 12288 * 4);
constexpr size_t WS_HGL = al256(WS_PART + (size_t)32 * 5 * 12288 * 4);
constexpr size_t WS_HGC = al256(WS_HGL + (size_t)2 * 512 * 4096 * 4);
constexpr size_t WS_INORM = al256(WS_HGC + (size_t)2 * 512 * 256 * 4);
constexpr size_t WS_XC = al256(WS_INORM + 1024 * 4);
constexpr size_t WS_A = al256(WS_XC + (size_t)1024 * 2048 * 4);
constexpr size_t WS_PX = al256(WS_A + (size_t)T_ALL * 2048 * 2);
constexpr size_t WS_WO = al256(WS_PX + (size_t)T_ALL * NINP * 2);
constexpr size_t WS_W1 = al256(WS_WO + (size_t)2048 * 2048 * 2);
constexpr size_t WS_W2 = al256(WS_W1 + (size_t)8192 * 2048 * 2);
constexpr size_t WS_WIN = al256(WS_W2 + (size_t)2048 * 8192 * 2);
constexpr size_t WS_H = al256(WS_WIN + (size_t)NINP * 2048 * 2);
constexpr size_t WS_LW = al256(WS_H + (size_t)T_ALL * 8192 * 2);
constexpr size_t WS_RGW = WS_LW + 2 * 262144;
constexpr size_t WS_BAR = WS_RGW + 16 * 32768;
constexpr size_t WS_END = WS_BAR + 16384;
constexpr size_t MSU = (size_t)T_ALL * 512 * 2;

struct Params { const float* in[43]; float* out; unsigned char* ws; };

DI float bf2f(bf16_t v) { return __uint_as_float((unsigned)v << 16); }
DI bf16_t f2bf(float f) { unsigned u = __float_as_uint(f); return (bf16_t)((u + 0x7fffu + ((u >> 16) & 1u)) >> 16); }
DI unsigned pk2(float lo, float hi) { return (unsigned)f2bf(lo) | ((unsigned)f2bf(hi) << 16); }
DI float bflo(unsigned w) { return __uint_as_float(w << 16); }
DI float bfhi(unsigned w) { return __uint_as_float(w & 0xffff0000u); }
DI float wave_sum(float v) {
#pragma unroll
    for (int o = 1; o < 64; o <<= 1) v += __shfl_xor(v, o);
    return v;
}
#define DPPF(v, ctrl) __builtin_bit_cast(float, __builtin_amdgcn_mov_dpp(__builtin_bit_cast(int, (v)), (ctrl), 0xF, 0xF, true))
DI float wave_sum_fast(float v) {
    v += DPPF(v, 0xB1); v += DPPF(v, 0x4E); v += DPPF(v, 0x141); v += DPPF(v, 0x140);
    const int iv = __builtin_bit_cast(int, v);
    return (__builtin_bit_cast(float, __builtin_amdgcn_readlane(iv, 0)) + __builtin_bit_cast(float, __builtin_amdgcn_readlane(iv, 16))) +
           (__builtin_bit_cast(float, __builtin_amdgcn_readlane(iv, 32)) + __builtin_bit_cast(float, __builtin_amdgcn_readlane(iv, 48)));
}
DI float sigm(float x) { return __builtin_amdgcn_rcpf(1.f + __expf(-x)); }
DI float siluf(float x) { return x * __builtin_amdgcn_rcpf(1.f + __expf(-x)); }
DI float tanh_fast(float x) { return 1.f - 2.f * __builtin_amdgcn_rcpf(1.f + __expf(2.f * x)); }
DI float softplusf(float x) { return fmaxf(x, 0.f) + __logf(1.f + __expf(-fabsf(x))); }
DI float gelu_tanh(float x) { return 0.5f * x * (1.f + tanh_fast(0.7978845608f * (x + 0.044715f * x * x * x))); }
#define LDSW() asm volatile("s_waitcnt lgkmcnt(0)" ::: "memory")
#define LDS_BARRIER() do { asm volatile("s_waitcnt lgkmcnt(0)" ::: "memory"); __builtin_amdgcn_s_barrier(); asm volatile("" ::: "memory"); } while (0)

DI int scan_row(int n, int d, int b, bool& first) {
    if (n < 256) { const int tp = d ? 255 - n : n; first = (n == 0); return T_LAT + b * 256 + tp; }
    const int m = n - 256; const int tp = d ? 4095 - m : m; first = (m == 0); return b * 4096 + tp;
}

struct EpiStoreBf16 {
    static constexpr bool PERM = true, AFTER_DRAIN = false;
    bf16_t* O; int ldc; int act;
    DI void operator()(const pg8::f32x4 (&acc)[2][2][4][2], const pg8::Unit& u, int wr, int wc, int fr, int fq) const {
        const int row0 = u.pm * 256 + wr * 64 + fr, col0 = u.pn * 256 + wc * 32 + 8 * fq;
#pragma unroll
        for (int ai = 0; ai < 2; ++ai)
#pragma unroll
            for (int m = 0; m < 4; ++m) { bf16_t* rowp = O + (size_t)(row0 + ai * 128 + m * 16) * ldc + col0;
#pragma unroll
                for (int bj = 0; bj < 2; ++bj) { f32x4 v0 = acc[ai][bj][m][0], v1 = acc[ai][bj][m][1];
                    if (act) {
#pragma unroll
                        for (int e = 0; e < 4; ++e) { const float a = fmaxf(v0[e], 0.f), b = fmaxf(v1[e], 0.f); v0[e] = a * a; v1[e] = b * b; } }
                    u32x4 w; w.x = pg8::cvt_pk_bf16(v0[0], v0[1]); w.y = pg8::cvt_pk_bf16(v0[2], v0[3]); w.z = pg8::cvt_pk_bf16(v1[0], v1[1]); w.w = pg8::cvt_pk_bf16(v1[2], v1[3]);
                    if (act) __builtin_nontemporal_store(w, (u32x4*)(rowp + bj * 128));
                    else *(u32x4*)(rowp + bj * 128) = w; } }
    }
};
struct EpiResidual {
    static constexpr bool PERM = false, AFTER_DRAIN = false;
    const float* baseL; const float* baseC; float* outL; float* outC; const float* gate;
    DI void operator()(const pg8::f32x4 (&acc)[2][2][4][2], const pg8::Unit& u, int wr, int wc, int fr, int fq) const {
        const bool isc = u.pm >= 64; const int bi = isc ? 4 : (u.pm >> 4);
        const int rloc = (isc ? (u.pm - 64) : u.pm) * 256 + wr * 64 + fr;
        const float* base = isc ? baseC : baseL; float* out = isc ? outC : outL;
        const int col0 = u.pn * 256 + wc * 32 + 4 * fq;
        const float* gp = gate + (size_t)bi * 12288 + col0;
        f32x4 g4[2][2];
#pragma unroll
        for (int bj = 0; bj < 2; ++bj)
#pragma unroll
            for (int n = 0; n < 2; ++n) g4[bj][n] = *(const f32x4*)(gp + bj * 128 + n * 16);
#pragma unroll
        for (int ai = 0; ai < 2; ++ai)
#pragma unroll
            for (int m = 0; m < 4; ++m) { const size_t off = (size_t)(rloc + ai * 128 + m * 16) * DM + col0;
#pragma unroll
                for (int bj = 0; bj < 2; ++bj)
#pragma unroll
                    for (int n = 0; n < 2; ++n) { const f32x4 bs = *(const f32x4*)(base + off + bj * 128 + n * 16);
                        *(f32x4*)(out + off + bj * 128 + n * 16) = bs + g4[bj][n] * acc[ai][bj][m][n]; }
                asm volatile("" ::: "memory"); }
    }
};

struct OneUnit {
    int pm, pn;
    DI bool next(int i, pg8::Unit& u) const { if (i != 0) return false; u.pm = pm; u.pn = pn; return true; }
    DI void a_ready(const pg8::Unit&) const {}
    DI void done(const pg8::Unit&) const {}
};
struct EpiSlab {
    static constexpr bool PERM = false, AFTER_DRAIN = false;
    float* slab; const float* gate;
    DI void operator()(const pg8::f32x4 (&acc)[2][2][4][2], const pg8::Unit& u, int wr, int wc, int fr, int fq) const {
        const int rloc = u.pm * 256 + wr * 64 + fr, col0 = u.pn * 256 + wc * 32 + 4 * fq;
        const float* gp = gate + (size_t)4 * 12288 + col0;
        f32x4 g4[2][2];
#pragma unroll
        for (int bj = 0; bj < 2; ++bj)
#pragma unroll
            for (int n = 0; n < 2; ++n) g4[bj][n] = *(const f32x4*)(gp + bj * 128 + n * 16);
#pragma unroll
        for (int ai = 0; ai < 2; ++ai)
#pragma unroll
            for (int m = 0; m < 4; ++m) { float* o = slab + (size_t)(rloc + ai * 128 + m * 16) * DM + col0;
#pragma unroll
                for (int bj = 0; bj < 2; ++bj)
#pragma unroll
                    for (int n = 0; n < 2; ++n) *(f32x4*)(o + bj * 128 + n * 16) = g4[bj][n] * acc[ai][bj][m][n]; }
    }
};

DI void tr_item(const float* W, int K, int N, int Npad, bf16_t* WT, float* scr, int item, int lane) {
    const int nblk = Npad / 32, kb = item / nblk, nb = item % nblk, k0 = 64 * kb, n0 = 32 * nb;
    const int n = n0 + (lane & 31);
    float tv[32];
#pragma unroll
    for (int i = 0; i < 32; ++i) { const int kk = 2 * i + (lane >> 5); tv[i] = (n < N) ? W[(size_t)(k0 + kk) * N + n] : 0.f; }
#pragma unroll
    for (int i = 0; i < 32; ++i) { const int kk = 2 * i + (lane >> 5); scr[kk * 33 + (lane & 31)] = tv[i]; }
    LDSW();
    const int c = lane & 7;
#pragma unroll
    for (int j = 0; j < 4; ++j) { const int nn = (lane >> 3) + 8 * j; const float* s = scr + (8 * c) * 33 + nn;
        u32x4 o; o.x = pk2(s[0 * 33], s[1 * 33]); o.y = pk2(s[2 * 33], s[3 * 33]); o.z = pk2(s[4 * 33], s[5 * 33]); o.w = pk2(s[6 * 33], s[7 * 33]);
        *(u32x4*)(WT + (size_t)(n0 + nn) * K + k0 + 8 * c) = o; }
    LDSW();
}

DI void ph_weights(const Params& p, int l, unsigned char* lds, int gw, int ngw, int wave, int lane) {
    float* scr = (float*)(lds + wave * 8448);
    const float* win = p.in[8] + (size_t)l * 2048 * NIN; const float* wo = p.in[9] + (size_t)l * 2048 * 2048;
    const float* w1 = p.in[40] + (size_t)l * 2048 * 8192; const float* w2 = p.in[41] + (size_t)l * 8192 * 2048;
    bf16_t* WinT = (bf16_t*)(p.ws + WS_WIN); bf16_t* WoT = (bf16_t*)(p.ws + WS_WO); bf16_t* W1T = (bf16_t*)(p.ws + WS_W1); bf16_t* W2T = (bf16_t*)(p.ws + WS_W2);
    constexpr int I_IN = 32 * (NINP / 32), I_O = 32 * 64, I_1 = 32 * 256, I_2 = 128 * 64;
    for (int it = gw; it < I_IN + I_O + I_1 + I_2 + 256; it += ngw) {
        int r = it;
        if (r < I_IN) { tr_item(win, 2048, NIN, NINP, WinT, scr, r, lane); continue; } r -= I_IN;
        if (r < I_O) { tr_item(wo, 2048, 2048, 2048, WoT, scr, r, lane); continue; } r -= I_O;
        if (r < I_1) { tr_item(w1, 2048, 8192, 8192, W1T, scr, r, lane); continue; } r -= I_1;
        if (r < I_2) { tr_item(w2, 8192, 2048, 2048, W2T, scr, r, lane); continue; } r -= I_2;
        if (r < 128) { const int d = r >> 6, q = r & 63; bf16_t* base = (bf16_t*)(p.ws + WS_LW) + (size_t)d * 131072;
            if (q < 16) tr_item(p.in[20] + (size_t)(l * 2 + d) * 64 * 512, 64, 512, 512, base, scr, q, lane);
            else if (q < 32) tr_item(p.in[22] + (size_t)(l * 2 + d) * 64 * 512, 64, 512, 512, base + 32768, scr, q - 16, lane);
            else tr_item(p.in[23] + (size_t)(l * 2 + d) * 128 * 512, 128, 512, 512, base + 65536, scr, q - 32, lane);
            continue; } r -= 128;
        { const int mat = r >> 3, q = r & 7; const int d = mat >> 3, gate = (mat >> 2) & 1, n = mat & 3;
          const float* src = (gate ? p.in[37] : p.in[35]) + ((size_t)((l * 2 + d) * 4 + n) * 128) * 128;
          tr_item(src, 128, 128, 128, (bf16_t*)(p.ws + WS_RGW) + (size_t)mat * 16384, scr, q, lane); }
    }
}

DI void ph_ada_partial(const Params& p, int l, unsigned char* lds, int bid, int G, int tid) {
    float* sl = (float*)lds;
    const float* aw = p.in[4] + (size_t)l * 2048 * 12288;
    float* PART = (float*)(p.ws + WS_PART);
    for (int it = bid; it < 24 * 32; it += G) {
        const int cb = it % 24, kc = it / 24;
        __syncthreads();
        if (tid < 320) { const int i = tid >> 6, kk = tid & 63; const float c = i < 4 ? p.in[1][i * 2048 + kc * 64 + kk] : p.in[3][kc * 64 + kk]; sl[tid] = siluf(c); }
        __syncthreads();
        const int col = cb * 512 + tid; float acc[5] = {0.f, 0.f, 0.f, 0.f, 0.f};
        const float* wp = aw + (size_t)(kc * 64) * 12288 + col;
#pragma unroll 32
        for (int kk = 0; kk < 64; ++kk) { const float w = wp[(size_t)kk * 12288];
#pragma unroll
            for (int i = 0; i < 5; ++i) acc[i] += sl[i * 64 + kk] * w; }
#pragma unroll
        for (int i = 0; i < 5; ++i) PART[((size_t)kc * 5 + i) * 12288 + col] = acc[i];
    }
    __syncthreads();
}

DI void ph_hyfilt(const Params& p, int l, unsigned char* lds, int bid, int G, int tid) {
    float* feat = (float*)lds;
    float* h1 = feat + 16 * 33;
    float* h2T = h1 + 16 * 64;
    float* w1s = h2T + 64 * 16;
    float* w2s = w1s + 33 * 64;
    const float* b1 = p.in[12] + l * 64; const float* b2 = p.in[14] + l * 64;
    const float* w3 = p.in[15] + (size_t)l * 64 * 1024; const float* fq = p.in[16] + l * 128;
    const int nitems = (l == 0) ? 256 + 16 : 256;
    __syncthreads();
    for (int idx = tid; idx < 33 * 64; idx += 512) w1s[idx] = p.in[11][(size_t)l * 33 * 64 + idx];
    for (int idx = tid; idx < 64 * 64; idx += 512) w2s[idx] = p.in[13][(size_t)l * 64 * 64 + idx];
    for (int it = (bid + 128) % G; it < nitems; it += G) {
        const int L = it < 256 ? 4096 : 256; const int t0 = (it < 256 ? it : it - 256) * 16;
        float* HG = (float*)(p.ws + (it < 256 ? WS_HGL : WS_HGC));
        const float invLm1 = 1.f / (float)(L - 1);
        __syncthreads();
        for (int idx = tid; idx < 16 * 33; idx += 512) { const int tt = idx / 33, f = idx % 33; const float t = (float)(t0 + tt); float val;
            if (f == 0) val = t * invLm1;
            else { const int i = (f - 1) & 15; const float band = 1e-4f + (float)i * ((15.f - 1e-4f) / 15.f); const float ang = (6.283185307179586f / (float)L) * t * band; val = (f <= 16) ? cosf(ang) : -sinf(ang); }
            feat[idx] = val; }
        __syncthreads();
        for (int o = tid; o < 1024; o += 512) { const int tt = o >> 6, j = o & 63; float acc = 0.f;
#pragma unroll
            for (int f = 0; f < 33; ++f) acc += feat[tt * 33 + f] * w1s[f * 64 + j];
            h1[tt * 64 + j] = sinf(fq[j] * (acc + b1[j])); }
        __syncthreads();
        for (int o = tid; o < 1024; o += 512) { const int tt = o >> 6, j = o & 63; float acc = 0.f;
#pragma unroll 16
            for (int i = 0; i < 64; ++i) acc += h1[tt * 64 + i] * w2s[i * 64 + j];
            h2T[j * 16 + tt] = sinf(fq[64 + j] * (acc + b2[j])); }
        __syncthreads();
        float accA[16], accB[16];
#pragma unroll
        for (int tt = 0; tt < 16; ++tt) { accA[tt] = 0.f; accB[tt] = 0.f; }
#pragma unroll 8
        for (int i = 0; i < 64; ++i) { const float wa = w3[i * 1024 + tid], wb = w3[i * 1024 + 512 + tid];
#pragma unroll
            for (int q = 0; q < 4; ++q) { const f32x4 hv = *(const f32x4*)(h2T + i * 16 + 4 * q);
#pragma unroll
                for (int e = 0; e < 4; ++e) { accA[4 * q + e] += hv[e] * wa; accB[4 * q + e] += hv[e] * wb; } } }
        const float delta = 3.0701134573253944f + (float)tid * (12.280453829301578f / 511.f);
        float* dA = HG + (size_t)tid * L + t0; float* dB = HG + (size_t)(512 + tid) * L + t0;
#pragma unroll
        for (int q = 0; q < 4; ++q) { f32x4 oa, ob;
#pragma unroll
            for (int e = 0; e < 4; ++e) { const float z = (float)(t0 + 4 * q + e) * invLm1; const float dec = expf(-z * delta); oa[e] = accA[4 * q + e] * dec; ob[e] = accB[4 * q + e] * dec; }
            *(f32x4*)(dA + 4 * q) = oa; *(f32x4*)(dB + 4 * q) = ob; }
    }
    __syncthreads();
}

DI void ph_b(const Params& p, int l, int bid, int G, int tid, int gw, int ngw, int lane) {
    const float* PART = (const float*)(p.ws + WS_PART); float* MOD = (float*)(p.ws + WS_MOD);
    const float* ab = p.in[5] + (size_t)l * 12288;
    for (int idx = bid * 512 + tid; idx < 5 * 12288; idx += G * 512) { const int i = idx / 12288, col = idx % 12288; float s = ab[col];
#pragma unroll
        for (int kc = 0; kc < 32; ++kc) s += PART[((size_t)kc * 5 + i) * 12288 + col];
        MOD[idx] = s; }
    float* INORM = (float*)(p.ws + WS_INORM);
    const int nit = (l == 0) ? 1024 : 512;
    for (int it = gw; it < nit; it += ngw) { const int c = it & 511; const int L = it < 512 ? 4096 : 256;
        const float* HG = (const float*)(p.ws + (it < 512 ? WS_HGL : WS_HGC));
        const float* gf = HG + (size_t)c * L; const float* gb = HG + (size_t)(512 + c) * L; float s = 0.f;
        for (int t = lane; t < L; t += 64) s += fabsf(gf[t]) + (t > 0 ? fabsf(gb[t]) : 0.f);
        s = wave_sum(s);
        if (lane == 0) INORM[it] = 1.f / s; }
}

DI void ph_norm(const Params& p, const float* xl, const float* xc, const float* g, int sh_idx, int sc_idx, int M, int gw, int ngw, int lane, int comb_gate) {
    const float* MOD = (const float*)(p.ws + WS_MOD); bf16_t* A = (bf16_t*)(p.ws + WS_A);
    f32x4 gs[8], hh[8];
#define NORM_PARAMS(bi_) do { const float* sh_ = MOD + (size_t)(bi_) * 12288 + sh_idx * 2048 + 4 * lane; const float* sc_ = MOD + (size_t)(bi_) * 12288 + sc_idx * 2048 + 4 * lane; \
        _Pragma("unroll") for (int j = 0; j < 8; ++j) { gs[j] = *(const f32x4*)(g + 4 * lane + 256 * j) * (*(const f32x4*)(sc_ + 256 * j) + 1.f); hh[j] = *(const f32x4*)(sh_ + 256 * j); } } while (0)
#define NORM_EMIT(v_, r_) do { float ss_ = 0.f; _Pragma("unroll") for (int j = 0; j < 8; ++j) ss_ += (v_[j][0] * v_[j][0] + v_[j][1] * v_[j][1]) + (v_[j][2] * v_[j][2] + v_[j][3] * v_[j][3]); \
        ss_ = wave_sum_fast(ss_); const float rs_ = rsqrtf(ss_ * (1.f / 2048.f) + 1e-6f); \
        _Pragma("unroll") for (int j = 0; j < 8; ++j) { const f32x4 y_ = (v_[j] * rs_) * gs[j] + hh[j]; u32x2 w_; w_.x = pk2(y_[0], y_[1]); w_.y = pk2(y_[2], y_[3]); \
            *(u32x2*)(A + (size_t)(r_) * DM + 4 * lane + 256 * j) = w_; } } while (0)
    const int nrow = (T_LAT + ngw - 1) / ngw; const int r0 = gw * nrow, r1 = (r0 + nrow < T_LAT) ? r0 + nrow : T_LAT;
    if (r0 < r1) {
        int bi = r0 >> 12; NORM_PARAMS(bi);
        f32x4 v[8], vn[8];
#pragma unroll
        for (int j = 0; j < 8; ++j) v[j] = *(const f32x4*)(xl + (size_t)r0 * DM + 4 * lane + 256 * j);
        for (int r = r0; r < r1; ++r) {
            const int rn = (r + 1 < r1) ? r + 1 : r;
#pragma unroll
            for (int j = 0; j < 8; ++j) vn[j] = *(const f32x4*)(xl + (size_t)rn * DM + 4 * lane + 256 * j);
            if ((r >> 12) != bi) { bi = r >> 12; NORM_PARAMS(bi); }
            NORM_EMIT(v, r);
#pragma unroll
            for (int j = 0; j < 8; ++j) v[j] = vn[j];
        }
    }
    if (M > T_LAT) {
        NORM_PARAMS(4);
        for (int r = T_LAT + gw; r < M; r += ngw) {
            const float* src = xc + (size_t)(r - T_LAT) * DM; f32x4 v[8];
#pragma unroll
            for (int j = 0; j < 8; ++j) v[j] = *(const f32x4*)(src + 4 * lane + 256 * j);
            if (comb_gate >= 0) {
                const float* sl = (const float*)(p.ws + WS_PX) + (size_t)(r - T_LAT) * DM + 4 * lane;
#pragma unroll
                for (int j = 0; j < 8; ++j) { f32x4 a = *(const f32x4*)(sl + 256 * j);
#pragma unroll
                    for (int ks = 1; ks < 8; ++ks) a += *(const f32x4*)(sl + (size_t)ks * 1024 * DM + 256 * j);
                    v[j] += a;
                    *(f32x4*)((float*)(p.ws + WS_XC) + (size_t)(r - T_LAT) * DM + 4 * lane + 256 * j) = v[j]; }
            }
            NORM_EMIT(v, r);
        }
    }
#undef NORM_PARAMS
#undef NORM_EMIT
}

DI void ph_rw_prep(const Params& p, int l, unsigned char* lds, int bid, int G, int tid) {
    typedef short bf16x8 __attribute__((ext_vector_type(8)));
    bf16_t* X = (bf16_t*)lds;
    const bf16_t* PX = (const bf16_t*)(p.ws + WS_PX);
    const int lane = tid & 63, w = __builtin_amdgcn_readfirstlane(tid >> 6), li = lane & 15, q = lane >> 4;
    for (int it = bid; it < 2 * 272; it += G) {
        const int d = it / 272, row0 = (it % 272) * 64;
        const float* mu = p.in[18] + (size_t)(l * 2 + d) * 1792 + 1536;
        __syncthreads();
#pragma unroll 8
        for (int i = 0; i < 16; ++i) { const int idx = tid + 512 * i; const int tok = idx >> 7, cp = idx & 127, col = 2 * cp; const int row = row0 + tok;
            const int t = row < T_LAT ? (row & 4095) : ((row - T_LAT) & 255); const int L = row < T_LAT ? 4096 : 256;
            const bool valid = d ? (t < L - 1) : (t > 0); const int pr = d ? row + 1 : row - 1;
            const unsigned uv = *(const unsigned*)(PX + (size_t)row * NINP + RWO + 1536 + col); const unsigned up = valid ? *(const unsigned*)(PX + (size_t)pr * NINP + RWO + 1536 + col) : 0u;
            const float v0 = bflo(uv), v1 = bfhi(uv); const float m0 = v0 + (bflo(up) - v0) * mu[col], m1 = v1 + (bfhi(up) - v1) * mu[col + 1];
            const float o0 = col < 64 ? tanh_fast(m0) : (col < 128 ? m0 : sigm(m0)), o1 = col < 64 ? tanh_fast(m1) : (col < 128 ? m1 : sigm(m1));
            *(unsigned*)(X + tok * 264 + col) = pk2(o0, o1); }
        __syncthreads();
        const bf16_t* WT = (const bf16_t*)(p.ws + WS_LW) + (size_t)d * 131072;
#pragma unroll 1
        for (int part = 0; part < 3; ++part) {
            const int K = part == 2 ? 128 : 64, koff = part == 0 ? 0 : (part == 1 ? 64 : 128), nks = K / 32;
            const bf16_t* Wp = WT + (part == 0 ? 0 : (part == 1 ? 32768 : 65536));
            bf16_t* OUT = (bf16_t*)(p.ws + WS_H + (size_t)((part == 0 ? 0 : (part == 1 ? 2 : 4)) + d) * MSU);
            bf16x8 Af[4][4];
#pragma unroll
            for (int ct = 0; ct < 4; ++ct)
#pragma unroll
                for (int ks = 0; ks < 4; ++ks) if (ks < nks) Af[ct][ks] = *(const bf16x8*)(Wp + (size_t)(64 * w + 16 * ct + li) * K + 32 * ks + 8 * q);
            f32x4 bias[4];
#pragma unroll
            for (int ct = 0; ct < 4; ++ct) { const int ch = 64 * w + 16 * ct + 4 * q;
                bias[ct] = part == 0 ? *(const f32x4*)(p.in[19] + (l * 2 + d) * 512 + ch) : (part == 1 ? *(const f32x4*)(p.in[21] + (l * 2 + d) * 512 + ch) : (f32x4){0.f, 0.f, 0.f, 0.f}); }
#pragma unroll 1
            for (int tt = 0; tt < 4; ++tt) {
                bf16x8 Bf[4];
#pragma unroll
                for (int ks = 0; ks < 4; ++ks) if (ks < nks) Bf[ks] = *(const bf16x8*)(X + (16 * tt + li) * 264 + koff + 32 * ks + 8 * q);
#pragma unroll
                for (int ct = 0; ct < 4; ++ct) { f32x4 acc = (f32x4){0.f, 0.f, 0.f, 0.f};
#pragma unroll
                    for (int ks = 0; ks < 4; ++ks) if (ks < nks) acc = __builtin_amdgcn_mfma_f32_16x16x32_bf16(Af[ct][ks], Bf[ks], acc, 0, 0, 0);
                    acc += bias[ct];
                    if (part == 0) { for (int e = 0; e < 4; ++e) acc[e] = 0.6065306597126334f * sigm(acc[e]); }
                    else if (part == 1) { for (int e = 0; e < 4; ++e) acc[e] = sigm(acc[e]); }
                    u32x2 o; o.x = pk2(acc[0], acc[1]); o.y = pk2(acc[2], acc[3]);
                    *(u32x2*)(OUT + (size_t)(row0 + 16 * tt + li) * 512 + 64 * w + 16 * ct + 4 * q) = o; }
            }
        }
    }
    __syncthreads();
}

DI void ph_gd_prep(const Params& p, int l, unsigned char* lds, int bid, int G, int tid, int lane, int wave) {
    unsigned* buf = (unsigned*)lds;
    bf16_t* PX = (bf16_t*)(p.ws + WS_PX);
    const float* cw = p.in[29] + (size_t)l * 4 * 1536;
    for (int it = (bid + 192) % G; it < 3072 + 48; it += G) {
        int row0, NT, sl;
        if (it >= 48) { const int il = it - 48; const int b = il / 768, rem = il % 768; row0 = b * 4096 + (rem / 12) * 64; sl = rem % 12; NT = 64; }
        else { row0 = T_LAT + (it / 12) * 256; sl = it % 12; NT = 256; }
        const int col0 = GDO + sl * 128;
        __syncthreads();
#pragma unroll 8
        for (int idx = tid; idx < NT * 64; idx += 512) { const int tt = idx >> 6, c2 = idx & 63; buf[idx] = *(const unsigned*)(PX + (size_t)(row0 + tt) * NINP + col0 + 2 * c2); }
        __syncthreads();
        const int c = sl * 128 + 2 * lane;
        float w0[4], w1[4];
#pragma unroll
        for (int j = 0; j < 4; ++j) { w0[j] = cw[j * 1536 + c]; w1[j] = cw[j * 1536 + c + 1]; }
        for (int tt = wave; tt < NT; tt += 8) { float y0 = 0.f, y1 = 0.f;
#pragma unroll
            for (int j = 0; j < 4; ++j) { const int ts = tt - 2 + j; if (ts >= 0 && ts < NT) { const unsigned u = buf[ts * 64 + lane]; y0 += bflo(u) * w0[j]; y1 += bfhi(u) * w1[j]; } }
            y0 = siluf(y0); y1 = siluf(y1);
            if (sl < 8) { const float ss = wave_sum_fast(y0 * y0 + y1 * y1); const float sc = rsqrtf(ss + 1e-6f) * (sl < 4 ? 0.08838834764831845f : 1.f); y0 *= sc; y1 *= sc; }
            *(unsigned*)(PX + (size_t)(row0 + tt) * NINP + col0 + 2 * lane) = pk2(y0, y1); }
    }
    __syncthreads();
}

DI void ph_rg_prep(const Params& p, int l, unsigned char* lds, int bid, int G, int tid) {
    typedef short bf16x8 __attribute__((ext_vector_type(8)));
    bf16_t* X = (bf16_t*)lds;
    const bf16_t* PX = (const bf16_t*)(p.ws + WS_PX);
    const int lane = tid & 63, w = __builtin_amdgcn_readfirstlane(tid >> 6), li = lane & 15, q = lane >> 4;
    const int c = tid;
    float cw[4];
#pragma unroll
    for (int j = 0; j < 4; ++j) cw[j] = p.in[33][(size_t)l * 4 * 512 + j * 512 + c];
    const float cb = p.in[34][l * 512 + c];
    for (int it = (bid + 224) % G; it < 544; it += G) {
        const int row0 = it * 32; const bool lat = row0 < T_LAT; const int t0 = lat ? (row0 & 63) : ((row0 - T_LAT) & 255); const int tend = lat ? 64 : 256;
        __syncthreads();
        { bf16_t pxv[35];
          const bf16_t* px = PX + (size_t)row0 * NINP + RGO + c;
#pragma unroll
          for (int k = 0; k < 35; ++k) { const int tt = t0 + k - 2; pxv[k] = (tt >= 0 && tt < tend) ? px[(ptrdiff_t)(k - 2) * NINP] : (bf16_t)0; }
#pragma unroll
          for (int k = 0; k < 32; ++k) X[k * 520 + c] = f2bf(cb + bf2f(pxv[k]) * cw[0] + bf2f(pxv[k + 1]) * cw[1] + bf2f(pxv[k + 2]) * cw[2] + bf2f(pxv[k + 3]) * cw[3]); }
        __syncthreads();
        const int n = w >> 1, jh = w & 1;
#pragma unroll 1
        for (int d = 0; d < 2; ++d) {
            bf16_t* LA = (bf16_t*)(p.ws + WS_H + (size_t)(10 + d) * MSU); bf16_t* BB = (bf16_t*)(p.ws + WS_H + (size_t)(12 + d) * MSU);
            const bf16_t* WA = (const bf16_t*)(p.ws + WS_RGW) + (size_t)(d * 8 + n) * 16384; const bf16_t* WX = WA + (size_t)4 * 16384;
#pragma unroll 1
            for (int jt = 0; jt < 4; ++jt) {
                const int j = 64 * jh + 16 * jt + li; bf16x8 Ar[4], Ai[4];
#pragma unroll
                for (int ks = 0; ks < 4; ++ks) { Ar[ks] = *(const bf16x8*)(WA + (size_t)j * 128 + 32 * ks + 8 * q); Ai[ks] = *(const bf16x8*)(WX + (size_t)j * 128 + 32 * ks + 8 * q); }
                const int c4 = n * 128 + 64 * jh + 16 * jt + 4 * q;
                const f32x4 ba = *(const f32x4*)(p.in[36] + (l * 2 + d) * 512 + c4), bx = *(const f32x4*)(p.in[38] + (l * 2 + d) * 512 + c4), lam = *(const f32x4*)(p.in[39] + (l * 2 + d) * 512 + c4);
                f32x4 sp;
#pragma unroll
                for (int e = 0; e < 4; ++e) sp[e] = softplusf(-lam[e]);
#pragma unroll 1
                for (int tt = 0; tt < 2; ++tt) { f32x4 ar = (f32x4){0.f, 0.f, 0.f, 0.f}, ai = (f32x4){0.f, 0.f, 0.f, 0.f};
#pragma unroll
                    for (int ks = 0; ks < 4; ++ks) { const bf16x8 Bf = *(const bf16x8*)(X + (16 * tt + li) * 520 + n * 128 + 32 * ks + 8 * q);
                        ar = __builtin_amdgcn_mfma_f32_16x16x32_bf16(Ar[ks], Bf, ar, 0, 0, 0); ai = __builtin_amdgcn_mfma_f32_16x16x32_bf16(Ai[ks], Bf, ai, 0, 0, 0); }
                    const u32x2 xx = *(const u32x2*)(X + (16 * tt + li) * 520 + c4); const float xc[4] = {bflo(xx.x), bfhi(xx.x), bflo(xx.y), bfhi(xx.y)};
                    float la[4], bb[4];
#pragma unroll
                    for (int e = 0; e < 4; ++e) { const float gr = sigm(ar[e] + ba[e]), gi = sigm(ai[e] + bx[e]); la[e] = -8.f * gr * sp[e]; bb[e] = __builtin_amdgcn_sqrtf(fmaxf(1.f - __expf(2.f * la[e]), 0.f)) * (gi * xc[e]); }
                    u32x2 o1, o2; o1.x = pk2(la[0], la[1]); o1.y = pk2(la[2], la[3]); o2.x = pk2(bb[0], bb[1]); o2.y = pk2(bb[2], bb[3]);
                    const size_t oo = (size_t)(row0 + 16 * tt + li) * 512 + c4; *(u32x2*)(LA + oo) = o1; *(u32x2*)(BB + oo) = o2; }
            }
        }
    }
    __syncthreads();
}

DI void ph_hy_prep(const Params& p, int l, unsigned char* lds, int bid, int G, int tid) {
    const bf16_t* PX = (const bf16_t*)(p.ws + WS_PX);
    bf16_t* ZL = (bf16_t*)lds; bf16_t* XL = ZL + 512 * 64;
    __syncthreads();
    bf16_t* ZT = (bf16_t*)(p.ws + WS_H + (size_t)14 * MSU); bf16_t* X0T = (bf16_t*)(p.ws + WS_H + (size_t)15 * MSU);
    const float* cw = p.in[10] + (size_t)l * 3 * 1536; const int c = tid;
    float wv[3], w0[3], w1[3];
#pragma unroll
    for (int j = 0; j < 3; ++j) { wv[j] = cw[j * 1536 + c]; w0[j] = cw[j * 1536 + 512 + c]; w1[j] = cw[j * 1536 + 1024 + c]; }
    const int nit = (l == 0) ? 256 + 16 : 256;
    for (int it = (bid + 128) % G; it < nit; it += G) {
        int row0, L, t0, b; size_t zoff;
        if (it < 256) { b = it >> 6; t0 = (it & 63) * 64; L = 4096; row0 = b * 4096 + t0; zoff = ((size_t)b * 512 + c) * 4096 + t0; }
        else { const int ic = it - 256; b = ic >> 2; t0 = (ic & 3) * 64; L = 256; row0 = T_LAT + b * 256 + t0; zoff = (size_t)4 * 512 * 4096 + ((size_t)b * 512 + c) * 256 + t0; }
        const int rowlen = (it < 256) ? 64 : 256;
        const int tlo = (t0 / rowlen) * rowlen, thi = tlo + rowlen;
        float pv[3], p0[3], p1[3];
        { const bool ok = (t0 - 1) >= tlo; const bf16_t* q = PX + (size_t)(row0 - 1) * NINP + HYO + c;
          pv[0] = ok ? bf2f(q[0]) : 0.f; p0[0] = ok ? bf2f(q[512]) : 0.f; p1[0] = ok ? bf2f(q[1024]) : 0.f; }
        { const bf16_t* q = PX + (size_t)row0 * NINP + HYO + c; pv[1] = bf2f(q[0]); p0[1] = bf2f(q[512]); p1[1] = bf2f(q[1024]); }
#pragma unroll 1
        for (int k8 = 0; k8 < 8; ++k8) { unsigned zz[4], xx[4];
#pragma unroll
            for (int k = 0; k < 8; ++k) { const int tt = k8 * 8 + k; const bool ok = (t0 + tt + 1) < thi; const bf16_t* q = PX + (size_t)(row0 + tt + 1) * NINP + HYO + c;
                pv[2] = ok ? bf2f(q[0]) : 0.f; p0[2] = ok ? bf2f(q[512]) : 0.f; p1[2] = ok ? bf2f(q[1024]) : 0.f;
                const float v = pv[0] * wv[0] + pv[1] * wv[1] + pv[2] * wv[2], x0 = p0[0] * w0[0] + p0[1] * w0[1] + p0[2] * w0[2], x1 = p1[0] * w1[0] + p1[1] * w1[1] + p1[2] * w1[2];
                const unsigned zb = f2bf(x1 * v), xb = f2bf(x0);
                if (k & 1) { zz[k >> 1] |= zb << 16; xx[k >> 1] |= xb << 16; } else { zz[k >> 1] = zb; xx[k >> 1] = xb; }
                pv[0] = pv[1]; pv[1] = pv[2]; p0[0] = p0[1]; p0[1] = p0[2]; p1[0] = p1[1]; p1[1] = p1[2]; }
            u32x4 zo, xo; zo.x = zz[0]; zo.y = zz[1]; zo.z = zz[2]; zo.w = zz[3]; xo.x = xx[0]; xo.y = xx[1]; xo.z = xx[2]; xo.w = xx[3];
            *(u32x4*)(ZL + c * 64 + k8 * 8) = zo; *(u32x4*)(XL + c * 64 + k8 * 8) = xo; }
        (void)L;
        __syncthreads();
        {
            const int lane = tid & 63, w = tid >> 6, cs = lane >> 3, ck = lane & 7;
#pragma unroll
            for (int i = 0; i < 8; ++i) { const int ch = 64 * w + 8 * i + cs; const size_t zo2 = zoff + ((size_t)ch - c) * (size_t)(it < 256 ? 4096 : 256) + 8 * ck;
                *(u32x4*)(ZT + zo2) = *(const u32x4*)(ZL + ch * 64 + 8 * ck); *(u32x4*)(X0T + zo2) = *(const u32x4*)(XL + ch * 64 + 8 * ck); }
        }
        __syncthreads();
    }
}

typedef float f32x2v __attribute__((ext_vector_type(2)));

DI void rw_scan(const Params& p, int l, int item, unsigned char* lds, int tid, int lane, int wave) {
    const int d = item >> 6, b = (item >> 4) & 3, h = (item >> 1) & 7, rh = item & 1;
    float* SB = (float*)lds;
    float* YB = (float*)(lds + 2 * 32 * 392 * 4);
    const bf16_t* PX = (const bf16_t*)(p.ws + WS_PX);
    const bf16_t* E = (const bf16_t*)(p.ws + WS_H + (size_t)(0 + d) * MSU); const bf16_t* AA = (const bf16_t*)(p.ws + WS_H + (size_t)(2 + d) * MSU);
    bf16_t* Y = (bf16_t*)(p.ws + WS_H + (size_t)(6 + d) * MSU);
    __syncthreads();
    if (wave >= 4) {
        const int hw = wave - 4, ch = h * 64 + lane;
        const float* mu = p.in[18] + (size_t)(l * 2 + d) * 1792;
        const float mur = mu[ch], muk = mu[512 + ch], muv = mu[1024 + ch];
        const float kkw = p.in[24][(l * 2 + d) * 512 + ch], kaw = p.in[25][(l * 2 + d) * 512 + ch];
        bf16_t gr[8], gk[8], gv[8], gpr[8], gpk[8], gpv[8], ge[8], ga[8];
        bf16_t nr[8], nk[8], nv[8], npr[8], npk[8], npv[8], ne[8], na[8];
#define RW_GLOAD(blkx, R, K_, V_, PR, PK, PV, E_, A_) do { _Pragma("unroll") for (int j = 0; j < 8; ++j) { bool first; const int row = scan_row((blkx) * 32 + hw * 8 + j, d, b, first); \
            const bf16_t* q = PX + (size_t)row * NINP + RWO + ch; R[j] = q[0]; K_[j] = q[512]; V_[j] = q[1024]; \
            const bf16_t* qp = PX + (size_t)(first ? row : (d ? row + 1 : row - 1)) * NINP + RWO + ch; \
            PR[j] = first ? (bf16_t)0 : qp[0]; PK[j] = first ? (bf16_t)0 : qp[512]; PV[j] = first ? (bf16_t)0 : qp[1024]; \
            E_[j] = E[(size_t)row * 512 + ch]; A_[j] = AA[(size_t)row * 512 + ch]; } } while (0)
        RW_GLOAD(0, gr, gk, gv, gpr, gpk, gpv, ge, ga);
#pragma unroll 1
        for (int blk = -1; blk < 136; ++blk) {
            if (blk + 2 < 136) RW_GLOAD(blk + 2, nr, nk, nv, npr, npk, npv, ne, na);
            if (blk >= 1) {
                const int hid = hw * 64 + lane, s = hid >> 3, c4 = (hid & 7) * 4; bool first; const int row = scan_row((blk - 1) * 32 + s, d, b, first);
                const f32x4 y0 = *(const f32x4*)(YB + ((blk - 1) & 1) * 1024 + s * 32 + c4);
                u32x2 w2; w2.x = pk2(y0[0], y0[1]); w2.y = pk2(y0[2], y0[3]);
                *(u32x2*)(Y + (size_t)row * 512 + h * 64 + rh * 32 + c4) = w2; }
            if (blk + 1 < 136) {
                float* sbn = SB + ((blk + 1) & 1) * 32 * 392;
#pragma unroll
                for (int j = 0; j < 8; ++j) { float* st = sbn + (hw * 8 + j) * 392;
                    const float pr = bf2f(gr[j]), pk = bf2f(gk[j]), pv = bf2f(gv[j]);
                    const float r = pr + (bf2f(gpr[j]) - pr) * mur, k = pk + (bf2f(gpk[j]) - pk) * muk, v = pv + (bf2f(gpv[j]) - pv) * muv;
                    const float a = bf2f(ga[j]), w = __expf(-bf2f(ge[j])); const float kkr = k * kkw; const float n2 = wave_sum_fast(kkr * kkr);
                    const float kk = kkr * __builtin_amdgcn_rsqf(fmaxf(n2, 1e-24f)); const float kka = kk * a, kp = k * (1.f + (a - 1.f) * kaw);
                    const float c1 = wave_sum_fast(kka * r), c2 = wave_sum_fast(kp * r);
                    st[lane] = w; st[64 + lane] = kk; st[128 + lane] = kka; st[192 + lane] = kp; st[256 + lane] = w * r; st[320 + lane] = v; if (lane == 0) { st[384] = c1; st[385] = c2; } }
            }
#pragma unroll
            for (int j = 0; j < 8; ++j) { gr[j] = nr[j]; gk[j] = nk[j]; gv[j] = nv[j]; gpr[j] = npr[j]; gpk[j] = npk[j]; gpv[j] = npv[j]; ge[j] = ne[j]; ga[j] = na[j]; }
            LDS_BARRIER();
        }
#undef RW_GLOAD
        {
            const int hid = hw * 64 + lane, s = hid >> 3, c4 = (hid & 7) * 4; bool first; const int row = scan_row(135 * 32 + s, d, b, first);
            const f32x4 y0 = *(const f32x4*)(YB + (135 & 1) * 1024 + s * 32 + c4);
            u32x2 w2; w2.x = pk2(y0[0], y0[1]); w2.y = pk2(y0[2], y0[3]);
            *(u32x2*)(Y + (size_t)row * 512 + h * 64 + rh * 32 + c4) = w2; }
    } else {
        const int rloc = wave * 8 + (lane >> 3), rowv = rh * 32 + rloc, kq = lane & 7;
        f32x2v S[4];
#pragma unroll
        for (int i = 0; i < 4; ++i) S[i] = (f32x2v){0.f, 0.f};
        __builtin_amdgcn_s_setprio(3);
        LDS_BARRIER();
        struct Ops { f32x4 kkv[2], wrv[2], wv[2], kav[2], kpv[2]; float vv, c1, c2; };
#define RW_OPS(o, stp) do { const float* st_ = (stp); _Pragma("unroll") for (int r = 0; r < 2; ++r) { (o).kkv[r] = *(const f32x4*)(st_ + 64 + 4 * r); (o).wrv[r] = *(const f32x4*)(st_ + 256 + 4 * r); \
            (o).wv[r] = *(const f32x4*)(st_ + 4 * r); (o).kav[r] = *(const f32x4*)(st_ + 128 + 4 * r); (o).kpv[r] = *(const f32x4*)(st_ + 192 + 4 * r); } \
            (o).vv = st_[320 - 8 * kq + rowv]; (o).c1 = st_[384 - 8 * kq]; (o).c2 = st_[385 - 8 * kq]; } while (0)
#pragma unroll 1
        for (int blk = 0; blk < 136; ++blk) {
            const float* sb = SB + (blk & 1) * 32 * 392 + 8 * kq; float* yb = YB + (blk & 1) * 1024 + rloc;
            Ops cur; RW_OPS(cur, sb);
#pragma unroll
            for (int s = 0; s < 32; ++s) {
                Ops nxt; RW_OPS(nxt, sb + (s < 31 ? s + 1 : s) * 392);
                f32x2v sa = (f32x2v){0.f, 0.f}, sb2 = (f32x2v){0.f, 0.f}, ya = (f32x2v){0.f, 0.f}, yb2 = (f32x2v){0.f, 0.f};
#pragma unroll
                for (int r = 0; r < 2; ++r) { sa += S[2 * r] * (f32x2v){cur.kkv[r][0], cur.kkv[r][1]}; sb2 += S[2 * r + 1] * (f32x2v){cur.kkv[r][2], cur.kkv[r][3]};
                                              ya += S[2 * r] * (f32x2v){cur.wrv[r][0], cur.wrv[r][1]}; yb2 += S[2 * r + 1] * (f32x2v){cur.wrv[r][2], cur.wrv[r][3]}; }
                sa += sb2; ya += yb2;
                float sk = sa.x + sa.y, yy = ya.x + ya.y;
                sk += DPPF(sk, 0xB1); yy += DPPF(yy, 0xB1); sk += DPPF(sk, 0x4E); yy += DPPF(yy, 0x4E); sk += DPPF(sk, 0x141); yy += DPPF(yy, 0x141);
                const f32x2v vv2 = (f32x2v){cur.vv, cur.vv}, sk2 = (f32x2v){sk, sk};
#pragma unroll
                for (int r = 0; r < 2; ++r) {
                    S[2 * r] = S[2 * r] * (f32x2v){cur.wv[r][0], cur.wv[r][1]} + (vv2 * (f32x2v){cur.kpv[r][0], cur.kpv[r][1]} - sk2 * (f32x2v){cur.kav[r][0], cur.kav[r][1]});
                    S[2 * r + 1] = S[2 * r + 1] * (f32x2v){cur.wv[r][2], cur.wv[r][3]} + (vv2 * (f32x2v){cur.kpv[r][2], cur.kpv[r][3]} - sk2 * (f32x2v){cur.kav[r][2], cur.kav[r][3]}); }
                if (kq == 0) yb[s * 32] = yy - sk * cur.c1 + cur.vv * cur.c2;
                cur = nxt;
            }
            LDS_BARRIER();
        }
#undef RW_OPS
        __builtin_amdgcn_s_setprio(0);
    }
    __syncthreads();
}

DI void gd_scan(const Params& p, int l, int item, unsigned char* lds, int tid, int lane, int wave) {
    const int d = item >> 6, b = (item >> 4) & 3, h = (item >> 2) & 3, vq = item & 3;
    float* SB = (float*)lds;
    float* YB = (float*)(lds + 2 * 32 * 360 * 4);
    const bf16_t* PX = (const bf16_t*)(p.ws + WS_PX);
    bf16_t* O = (bf16_t*)(p.ws + WS_H + (size_t)(8 + d) * MSU);
    __syncthreads();
    if (wave >= 4) {
        const int hw = wave - 4;
        const float nA = -__expf(p.in[30][(l * 2 + d) * 4 + h]), dtb = p.in[31][(l * 2 + d) * 4 + h];
        const int kidx = ((2 * lane) >> 4) * 20 + ((2 * lane) & 15);
        unsigned gq[8], gk[8]; bf16_t gv[8], gg[8], gb[8]; unsigned nq[8], nk[8]; bf16_t nv[8], ng[8], nb[8];
#define GD_GLOAD(blkx, Q_, K_, V_, G_, B_) do { _Pragma("unroll") for (int j = 0; j < 8; ++j) { bool first; const int row = scan_row((blkx) * 32 + hw * 8 + j, d, b, first); \
            const bf16_t* q = PX + (size_t)row * NINP + GDO; Q_[j] = *(const unsigned*)(q + h * 128 + 2 * lane); K_[j] = *(const unsigned*)(q + 512 + h * 128 + 2 * lane); \
            V_[j] = q[1024 + h * 128 + vq * 32 + (lane & 31)]; G_[j] = q[2048 + d * 4 + h]; B_[j] = q[2048 + (2 + d) * 4 + h]; } } while (0)
        GD_GLOAD(0, gq, gk, gv, gg, gb);
#pragma unroll 1
        for (int blk = -1; blk < 136; ++blk) {
            if (blk + 2 < 136) GD_GLOAD(blk + 2, nq, nk, nv, ng, nb);
            if (blk >= 1) { const int hid = hw * 64 + lane, s = hid >> 3, c4 = (hid & 7) * 4; bool first; const int row = scan_row((blk - 1) * 32 + s, d, b, first);
                const f32x4 y0 = *(const f32x4*)(YB + ((blk - 1) & 1) * 1024 + s * 32 + c4);
                u32x2 w2; w2.x = pk2(y0[0], y0[1]); w2.y = pk2(y0[2], y0[3]); *(u32x2*)(O + (size_t)row * 512 + h * 128 + vq * 32 + c4) = w2; }
            if (blk + 1 < 136) {
                float* sbn = SB + ((blk + 1) & 1) * 32 * 360;
#pragma unroll
                for (int j = 0; j < 8; ++j) { float* st = sbn + (hw * 8 + j) * 360;
                    const float q0 = bflo(gq[j]), q1 = bfhi(gq[j]), k0 = bflo(gk[j]), k1 = bfhi(gk[j]); const float qk = wave_sum_fast(q0 * k0 + q1 * k1);
                    st[kidx] = k0; st[kidx + 1] = k1; st[160 + kidx] = q0; st[161 + kidx] = q1; if (lane < 32) st[320 + lane] = bf2f(gv[j]);
                    if (lane == 0) { const float xg = bf2f(gg[j]) + dtb; const float spl = fmaxf(xg, 0.f) + __logf(1.f + __expf(-fabsf(xg)));
                        st[352] = __expf(nA * spl); st[353] = sigm(bf2f(gb[j])); st[354] = qk; } }
            }
#pragma unroll
            for (int j = 0; j < 8; ++j) { gq[j] = nq[j]; gk[j] = nk[j]; gv[j] = nv[j]; gg[j] = ng[j]; gb[j] = nb[j]; }
            LDS_BARRIER();
        }
#undef GD_GLOAD
        { const int hid = hw * 64 + lane, s = hid >> 3, c4 = (hid & 7) * 4; bool first; const int row = scan_row(135 * 32 + s, d, b, first);
          const f32x4 y0 = *(const f32x4*)(YB + (135 & 1) * 1024 + s * 32 + c4);
          u32x2 w2; w2.x = pk2(y0[0], y0[1]); w2.y = pk2(y0[2], y0[3]); *(u32x2*)(O + (size_t)row * 512 + h * 128 + vq * 32 + c4) = w2; }
    } else {
        const int vloc = wave * 8 + (lane >> 3), kq = lane & 7;
        f32x2v S[8];
#pragma unroll
        for (int i = 0; i < 8; ++i) S[i] = (f32x2v){0.f, 0.f};
        __builtin_amdgcn_s_setprio(3);
        LDS_BARRIER();
        struct Ops { f32x4 kv[4], qv[4]; float vv, alpha, beta, qk; };
#define GD_OPS(o, stp) do { const float* st_ = (stp); _Pragma("unroll") for (int r = 0; r < 4; ++r) { (o).kv[r] = *(const f32x4*)(st_ + kq * 20 + 4 * r); (o).qv[r] = *(const f32x4*)(st_ + 160 + kq * 20 + 4 * r); } \
            (o).vv = st_[320 + vloc]; (o).alpha = st_[352]; (o).beta = st_[353]; (o).qk = st_[354]; } while (0)
#pragma unroll 1
        for (int blk = 0; blk < 136; ++blk) {
            const float* sb = SB + (blk & 1) * 32 * 360; float* yb = YB + (blk & 1) * 1024 + vloc;
            Ops cur; GD_OPS(cur, sb);
#pragma unroll
            for (int s = 0; s < 32; ++s) {
                Ops nxt; GD_OPS(nxt, sb + (s < 31 ? s + 1 : s) * 360);
                f32x2v ka = (f32x2v){0.f, 0.f}, kb = (f32x2v){0.f, 0.f}, qa = (f32x2v){0.f, 0.f}, qb = (f32x2v){0.f, 0.f};
#pragma unroll
                for (int r = 0; r < 4; ++r) { ka += S[2 * r] * (f32x2v){cur.kv[r][0], cur.kv[r][1]}; kb += S[2 * r + 1] * (f32x2v){cur.kv[r][2], cur.kv[r][3]};
                                              qa += S[2 * r] * (f32x2v){cur.qv[r][0], cur.qv[r][1]}; qb += S[2 * r + 1] * (f32x2v){cur.qv[r][2], cur.qv[r][3]}; }
                ka += kb; qa += qb;
                float kS = ka.x + ka.y, qS = qa.x + qa.y;
                kS += DPPF(kS, 0xB1); qS += DPPF(qS, 0xB1); kS += DPPF(kS, 0x4E); qS += DPPF(qS, 0x4E); kS += DPPF(kS, 0x141); qS += DPPF(qS, 0x141);
                const float vnew = cur.beta * (cur.vv - cur.alpha * kS);
                const f32x2v al2 = (f32x2v){cur.alpha, cur.alpha}, vn2 = (f32x2v){vnew, vnew};
#pragma unroll
                for (int r = 0; r < 4; ++r) { S[2 * r] = al2 * S[2 * r] + (f32x2v){cur.kv[r][0], cur.kv[r][1]} * vn2; S[2 * r + 1] = al2 * S[2 * r + 1] + (f32x2v){cur.kv[r][2], cur.kv[r][3]} * vn2; }
                if (kq == 0) yb[s * 32] = cur.alpha * qS + cur.qk * vnew;
                cur = nxt;
            }
            LDS_BARRIER();
        }
#undef GD_OPS
        __builtin_amdgcn_s_setprio(0);
    }
    __syncthreads();
}

DI void rg_scan(const Params& p, int item, unsigned char* lds, int lane, int wave) {
    const int d = item >> 5, b = (item >> 3) & 3, c = (item & 7) * 64 + lane;
    bf16_t* LA = (bf16_t*)(p.ws + WS_H + (size_t)(10 + d) * MSU); const bf16_t* BB = (const bf16_t*)(p.ws + WS_H + (size_t)(12 + d) * MSU);
    float* XP = (float*)lds;
    float* XH = XP + 512;
    const int st = d ? -1 : 1;
    float carry = 0.f;
    __syncthreads();
#pragma unroll 1
    for (int pass = 0; pass < 2; ++pass) {
        float h = carry, prod = 1.f;
        bf16_t cl[16], cb[16], nl[16], nb[16];
        { bool first; const int row0 = scan_row((wave * 34) * 16, d, b, first);
#pragma unroll
          for (int s = 0; s < 16; ++s) { const size_t o = (size_t)(row0 + st * s) * 512 + c; cl[s] = LA[o]; cb[s] = BB[o]; } }
#pragma unroll 2
        for (int bi = 0; bi < 34; ++bi) { const int blk = wave * 34 + bi; bool first;
            if (bi + 1 < 34) { const int rown = scan_row((blk + 1) * 16, d, b, first);
#pragma unroll
                for (int s = 0; s < 16; ++s) { const size_t o = (size_t)(rown + st * s) * 512 + c; nl[s] = LA[o]; nb[s] = BB[o]; } }
            const int row0 = scan_row(blk * 16, d, b, first);
#pragma unroll
            for (int s = 0; s < 16; ++s) { const float a = __expf(bf2f(cl[s])); h = a * h + bf2f(cb[s]); prod *= a; cl[s] = f2bf(h); }
            if (pass == 1) {
#pragma unroll
                for (int s = 0; s < 16; ++s) LA[(size_t)(row0 + st * s) * 512 + c] = cl[s]; }
#pragma unroll
            for (int s = 0; s < 16; ++s) { cl[s] = nl[s]; cb[s] = nb[s]; }
        }
        if (pass == 0) { XP[wave * 64 + lane] = prod; XH[wave * 64 + lane] = h;
            __syncthreads();
            float cr = 0.f;
            for (int w = 0; w < wave; ++w) cr = XP[w * 64 + lane] * cr + XH[w * 64 + lane];
            carry = cr; }
    }
    __syncthreads();
}

struct __attribute__((packed, aligned(4))) V16A4 { unsigned a, b, c, d; };
DI void hy_conv_mfma(const Params& p, int l, int c, unsigned char* lds, int tid) {
    typedef short bf16x8 __attribute__((ext_vector_type(8)));
    bf16_t* G0 = (bf16_t*)lds;
    bf16_t* G1 = G0 + 8208;
    bf16_t* Zs = G1 + 8208;
    bf16_t* ZT = (bf16_t*)(p.ws + WS_H + (size_t)14 * MSU); const bf16_t* X0T = (const bf16_t*)(p.ws + WS_H + (size_t)15 * MSU);
    const float* HG = (const float*)(p.ws + WS_HGL);
    const float inorm = ((const float*)(p.ws + WS_INORM))[c]; const float skip = p.in[17][l * 512 + c];
    __syncthreads();
    for (int idx = tid; idx < 8208; idx += 512) { const int x = idx - 4104; float v = 0.f;
        if (x >= -4095 && x <= 4095) v = x <= 0 ? HG[(size_t)c * 4096 - x] : HG[(size_t)(512 + c) * 4096 + x];
        const bf16_t bv = f2bf(v); G0[idx] = bv; if (idx + 1 < 8208) G1[idx + 1] = bv; if (idx == 0) G1[0] = 0; }
    for (int idx = tid; idx < 2048; idx += 512) { const int b = idx >> 9, rem = idx & 511, a = rem >> 3, j8 = rem & 7;
        *(u32x4*)(Zs + (b * 64 + a) * 72 + 8 * j8) = *(const u32x4*)(ZT + ((size_t)b * 512 + c) * 4096 + 64 * a + 8 * j8); }
    __syncthreads();
    const int lane = tid & 63, w = __builtin_amdgcn_readfirstlane(tid >> 6), i = lane & 15, q = lane >> 4;
    const int b = w >> 1, a0 = (w & 1) * 32;
    const bf16_t* gl = ((i & 1) ? G1 + 1 : G0) + 4104 + 8 * q - i;
    f32x4 acc[4][2];
#pragma unroll
    for (int m = 0; m < 4; ++m) { acc[m][0] = (f32x4){0.f, 0.f, 0.f, 0.f}; acc[m][1] = (f32x4){0.f, 0.f, 0.f, 0.f}; }
    bf16x8 F[6];
#pragma unroll
    for (int o = 0; o < 6; ++o) F[o] = (bf16x8){0, 0, 0, 0, 0, 0, 0, 0};
    const int dlo = a0 - 63, dhi = a0 + 31;
#pragma unroll 2
    for (int dl = dlo; dl <= dhi; ++dl) {
        const bf16_t* gd = gl - 64 * dl;
        if (dl == dlo) { F[4] = __builtin_bit_cast(bf16x8, *(const V16A4*)(gd + 16)); F[5] = __builtin_bit_cast(bf16x8, *(const V16A4*)(gd + 32)); }
        else { F[4] = F[0]; F[5] = F[1]; }
#pragma unroll
        for (int o = 0; o < 4; ++o) F[o] = __builtin_bit_cast(bf16x8, *(const V16A4*)(gd - 48 + 16 * o));
        bf16x8 Bf[2][2];
#pragma unroll
        for (int n = 0; n < 2; ++n) { const int ap = a0 + 16 * n + i - dl; const bool ok = (unsigned)ap < 64u; const int apc = ok ? ap : 0;
#pragma unroll
            for (int kk = 0; kk < 2; ++kk) { const bf16x8 v = *(const bf16x8*)(Zs + (b * 64 + apc) * 72 + 32 * kk + 8 * q); Bf[n][kk] = ok ? v : (bf16x8){0, 0, 0, 0, 0, 0, 0, 0}; } }
#pragma unroll
        for (int m = 0; m < 4; ++m)
#pragma unroll
            for (int n = 0; n < 2; ++n)
#pragma unroll
                for (int kk = 0; kk < 2; ++kk) acc[m][n] = __builtin_amdgcn_mfma_f32_16x16x32_bf16(F[2 * kk - m + 3], Bf[n][kk], acc[m][n], 0, 0, 0);
    }
#pragma unroll
    for (int m = 0; m < 4; ++m)
#pragma unroll
        for (int n = 0; n < 2; ++n) { const int a = a0 + 16 * n + i, i4 = 16 * m + 4 * q; const size_t o = ((size_t)b * 512 + c) * 4096 + 64 * a + i4;
            const u32x2 zz = *(const u32x2*)(Zs + (b * 64 + a) * 72 + i4); const u32x2 xx = *(const u32x2*)(X0T + o);
            const float y0 = acc[m][n][0] * inorm + bflo(zz.x) * skip, y1 = acc[m][n][1] * inorm + bfhi(zz.x) * skip, y2 = acc[m][n][2] * inorm + bflo(zz.y) * skip, y3 = acc[m][n][3] * inorm + bfhi(zz.y) * skip;
            u32x2 w2; w2.x = pk2(bflo(xx.x) * y0, bfhi(xx.x) * y1); w2.y = pk2(bflo(xx.y) * y2, bfhi(xx.y) * y3);
            *(u32x2*)(ZT + o) = w2; }
    __syncthreads();
}

template <int L>
DI void hy_conv(const Params& p, int l, int c, unsigned char* lds, int tid) {
    constexpr int NI = L >= 512 ? L / 512 : 1;
    float* zs = (float*)lds;
    float* gg = zs + L * 4;
    const bool isl = (L == 4096);
    bf16_t* ZT = (bf16_t*)(p.ws + WS_H + (size_t)14 * MSU) + (isl ? 0 : (size_t)4 * 512 * 4096);
    const bf16_t* X0T = (const bf16_t*)(p.ws + WS_H + (size_t)15 * MSU) + (isl ? 0 : (size_t)4 * 512 * 4096);
    const float* HG = (const float*)(p.ws + (isl ? WS_HGL : WS_HGC));
    const float inorm = ((const float*)(p.ws + WS_INORM))[(isl ? 0 : 512) + c];
    const float skip = p.in[17][l * 512 + c];
    __syncthreads();
    for (int idx = tid; idx < L * 4; idx += 512) { const int b = idx / L, t = idx % L; zs[t * 4 + b] = bf2f(ZT[((size_t)b * 512 + c) * L + t]); }
    for (int idx = tid; idx < 2 * L - 1; idx += 512) { const int dd = idx - (L - 1); gg[idx] = dd >= 0 ? HG[(size_t)c * L + dd] : HG[(size_t)(512 + c) * L - dd]; }
    __syncthreads();
    f32x4 acc[NI];
#pragma unroll
    for (int i = 0; i < NI; ++i) acc[i] = (f32x4){0.f, 0.f, 0.f, 0.f};
    const bool act = tid < L;
    if (act) {
        const float* gp = gg + (L - 1) + tid;
#pragma unroll 4
        for (int s = 0; s < L; ++s) { const f32x4 z4 = *(const f32x4*)(zs + 4 * s);
#pragma unroll
            for (int i = 0; i < NI; ++i) acc[i] += z4 * gp[512 * i - s]; }
#pragma unroll
        for (int i = 0; i < NI; ++i) { const int t = tid + 512 * i; const f32x4 z4 = *(const f32x4*)(zs + 4 * t);
#pragma unroll
            for (int b = 0; b < 4; ++b) { const size_t o = ((size_t)b * 512 + c) * L + t; const float y = acc[i][b] * inorm + z4[b] * skip; ZT[o] = f2bf(bf2f(X0T[o]) * y); } }
    }
    __syncthreads();
}

DI void ph_post(const Params& p, int l, unsigned char* lds, int gw, int ngw, int lane, int wave, int M) {
    const bf16_t* PX = (const bf16_t*)(p.ws + WS_PX); bf16_t* CAT = (bf16_t*)(p.ws + WS_A);
    const int ch = lane * 8;
    for (int row = gw; row < M; row += ngw) {
        float out[8];
#pragma unroll
        for (int e = 0; e < 8; ++e) out[e] = 0.f;
        const int t = row < T_LAT ? (row & 4095) : ((row - T_LAT) & 255); const int L = row < T_LAT ? 4096 : 256;
#pragma unroll 1
        for (int d = 0; d < 2; ++d) {
            const bool valid = d ? (t < L - 1) : (t > 0); const int pr = d ? row + 1 : row - 1;
            const float* mu = p.in[18] + (size_t)(l * 2 + d) * 1792; const int po = (l * 2 + d) * 512 + ch;
            const bf16_t* q = PX + (size_t)row * NINP + RWO + ch; const bf16_t* qp = PX + (size_t)(valid ? pr : row) * NINP + RWO + ch;
            const u32x4 ur = *(const u32x4*)q, uk = *(const u32x4*)(q + 512), uv = *(const u32x4*)(q + 1024);
            u32x4 pr4 = *(const u32x4*)qp, pk4 = *(const u32x4*)(qp + 512), pv4 = *(const u32x4*)(qp + 1024);
            const u32x4 ua = *(const u32x4*)((const bf16_t*)(p.ws + WS_H + (size_t)(2 + d) * MSU) + (size_t)row * 512 + ch);
            const u32x4 ug = *(const u32x4*)((const bf16_t*)(p.ws + WS_H + (size_t)(4 + d) * MSU) + (size_t)row * 512 + ch);
            const u32x4 uy = *(const u32x4*)((const bf16_t*)(p.ws + WS_H + (size_t)(6 + d) * MSU) + (size_t)row * 512 + ch);
            float r[8], k[8], v[8], a[8], g[8], y[8];
#pragma unroll
            for (int e = 0; e < 4; ++e) {
                const float r0 = bflo(ur[e]), r1 = bfhi(ur[e]), k0 = bflo(uk[e]), k1 = bfhi(uk[e]), v0 = bflo(uv[e]), v1 = bfhi(uv[e]);
                const float pr0 = valid ? bflo(pr4[e]) : 0.f, pr1 = valid ? bfhi(pr4[e]) : 0.f, pk0 = valid ? bflo(pk4[e]) : 0.f, pk1 = valid ? bfhi(pk4[e]) : 0.f, pv0 = valid ? bflo(pv4[e]) : 0.f, pv1 = valid ? bfhi(pv4[e]) : 0.f;
                r[2 * e] = r0 + (pr0 - r0) * mu[ch + 2 * e]; r[2 * e + 1] = r1 + (pr1 - r1) * mu[ch + 2 * e + 1];
                k[2 * e] = k0 + (pk0 - k0) * mu[512 + ch + 2 * e]; k[2 * e + 1] = k1 + (pk1 - k1) * mu[512 + ch + 2 * e + 1];
                v[2 * e] = v0 + (pv0 - v0) * mu[1024 + ch + 2 * e]; v[2 * e + 1] = v1 + (pv1 - v1) * mu[1024 + ch + 2 * e + 1];
                a[2 * e] = bflo(ua[e]); a[2 * e + 1] = bfhi(ua[e]); g[2 * e] = bflo(ug[e]); g[2 * e + 1] = bfhi(ug[e]); y[2 * e] = bflo(uy[e]); y[2 * e + 1] = bfhi(uy[e]); }
            float bs = 0.f, sy = 0.f;
#pragma unroll
            for (int e = 0; e < 8; ++e) { const float kp = k[e] * (1.f + (a[e] - 1.f) * p.in[25][po + e]); bs += r[e] * kp * p.in[26][po + e]; sy += y[e]; }
            bs += DPPF(bs, 0xB1); bs += DPPF(bs, 0x4E); bs += DPPF(bs, 0x141);
            sy += DPPF(sy, 0xB1); sy += DPPF(sy, 0x4E); sy += DPPF(sy, 0x141);
            const float mean = sy * (1.f / 64.f); float sv = 0.f;
#pragma unroll
            for (int e = 0; e < 8; ++e) { const float dd = y[e] - mean; sv += dd * dd; }
            sv += DPPF(sv, 0xB1); sv += DPPF(sv, 0x4E); sv += DPPF(sv, 0x141);
            const float rstd = rsqrtf(sv * (1.f / 64.f) + 64e-5f);
#pragma unroll
            for (int e = 0; e < 8; ++e) out[e] += ((y[e] - mean) * rstd * p.in[27][po + e] + p.in[28][po + e] + bs * v[e]) * g[e];
        }
        { u32x4 w; w.x = pk2(out[0], out[1]); w.y = pk2(out[2], out[3]); w.z = pk2(out[4], out[5]); w.w = pk2(out[6], out[7]); *(u32x4*)(CAT + (size_t)row * DM + 512 + ch) = w; }
        { const u32x4 o0 = *(const u32x4*)((const bf16_t*)(p.ws + WS_H + (size_t)8 * MSU) + (size_t)row * 512 + ch);
          const u32x4 o1 = *(const u32x4*)((const bf16_t*)(p.ws + WS_H + (size_t)9 * MSU) + (size_t)row * 512 + ch);
          const u32x4 uz = *(const u32x4*)(PX + (size_t)row * NINP + GDO + 1536 + ch);
          float o[8], z[8]; float ss = 0.f;
#pragma unroll
          for (int e = 0; e < 4; ++e) { o[2 * e] = bflo(o0[e]) + bflo(o1[e]); o[2 * e + 1] = bfhi(o0[e]) + bfhi(o1[e]); z[2 * e] = bflo(uz[e]); z[2 * e + 1] = bfhi(uz[e]); }
#pragma unroll
          for (int e = 0; e < 8; ++e) ss += o[e] * o[e];
          ss += DPPF(ss, 0xB1); ss += DPPF(ss, 0x4E); ss += DPPF(ss, 0x141); ss += DPPF(ss, 0x140);
          const float rs = rsqrtf(ss * (1.f / 128.f) + 1e-6f);
#pragma unroll
          for (int e = 0; e < 8; ++e) o[e] = o[e] * rs * p.in[32][l * 128 + ((ch + e) & 127)] * siluf(z[e]);
          u32x4 w; w.x = pk2(o[0], o[1]); w.y = pk2(o[2], o[3]); w.z = pk2(o[4], o[5]); w.w = pk2(o[6], o[7]); *(u32x4*)(CAT + (size_t)row * DM + 1024 + ch) = w; }
    }
    for (int row = gw; row < M; row += ngw) {
        const u32x4 hf = *(const u32x4*)((const bf16_t*)(p.ws + WS_H + (size_t)10 * MSU) + (size_t)row * 512 + ch);
        const u32x4 hb = *(const u32x4*)((const bf16_t*)(p.ws + WS_H + (size_t)11 * MSU) + (size_t)row * 512 + ch);
        const u32x4 ug = *(const u32x4*)(PX + (size_t)row * NINP + RGO + 512 + ch);
        u32x4 w;
#pragma unroll
        for (int e = 0; e < 4; ++e) w[e] = pk2(gelu_tanh(bflo(ug[e])) * (bflo(hf[e]) + bflo(hb[e])), gelu_tanh(bfhi(ug[e])) * (bfhi(hf[e]) + bfhi(hb[e])));
        *(u32x4*)(CAT + (size_t)row * DM + 1536 + ch) = w; }
    bf16_t* tile = (bf16_t*)(lds + wave * (64 * 66 * 2));
    const bf16_t* OT = (const bf16_t*)(p.ws + WS_H + (size_t)14 * MSU);
    const int nit = (M > T_LAT) ? 2048 + 128 : 2048;
    for (int it = gw; it < nit; it += ngw) {
        int b, t0, c0, L, rowb; size_t base;
        if (it < 2048) { b = it >> 9; t0 = ((it >> 3) & 63) * 64; c0 = (it & 7) * 64; L = 4096; rowb = b * 4096; base = 0; }
        else { const int ic = it - 2048; b = ic >> 5; t0 = ((ic >> 3) & 3) * 64; c0 = (ic & 7) * 64; L = 256; rowb = T_LAT + b * 256; base = (size_t)4 * 512 * 4096; }
        for (int i = 0; i < 64; ++i) tile[i * 66 + lane] = OT[base + ((size_t)b * 512 + c0 + i) * L + t0 + lane];
        LDSW();
        for (int j = 0; j < 64; ++j) CAT[(size_t)(rowb + t0 + j) * DM + c0 + lane] = tile[lane * 66 + j];
        LDSW();
    }
}

DI void ph_final(const Params& p, int gw, int ngw, int lane) {
    const float* g = p.in[42];
    f32x4 gg[8];
#pragma unroll
    for (int j = 0; j < 8; ++j) gg[j] = *(const f32x4*)(g + 4 * lane + 256 * j);
    const int nrow = (T_LAT + ngw - 1) / ngw; const int r0 = gw * nrow, r1 = (r0 + nrow < T_LAT) ? r0 + nrow : T_LAT;
    if (r0 >= r1) return;
    f32x4 v[8], vn[8];
#pragma unroll
    for (int j = 0; j < 8; ++j) v[j] = *(const f32x4*)(p.out + (size_t)r0 * DM + 4 * lane + 256 * j);
    for (int r = r0; r < r1; ++r) { const int rn = (r + 1 < r1) ? r + 1 : r;
#pragma unroll
        for (int j = 0; j < 8; ++j) vn[j] = *(const f32x4*)(p.out + (size_t)rn * DM + 4 * lane + 256 * j);
        float ss = 0.f;
#pragma unroll
        for (int j = 0; j < 8; ++j) ss += (v[j][0] * v[j][0] + v[j][1] * v[j][1]) + (v[j][2] * v[j][2] + v[j][3] * v[j][3]);
        ss = wave_sum_fast(ss); const float rs = rsqrtf(ss * (1.f / 2048.f) + 1e-6f);
#pragma unroll
        for (int j = 0; j < 8; ++j) *(f32x4*)(p.out + (size_t)r * DM + 4 * lane + 256 * j) = v[j] * rs * gg[j];
#pragma unroll
        for (int j = 0; j < 8; ++j) v[j] = vn[j]; }
}

#define LAS __attribute__((address_space(3)))
#define XB_TMO      128
#define XB_XCNT(j)  (256  + 64 * (j))
#define XB_XSUB(j)  (1280 + 64 * (j))
#define XB_XGEN(j)  (2304 + 64 * (j))
#define XB_TOP      3328
#define XB_TOPGEN   3392
#define XCD_BAR_WORDS 3456
#define XB_SPIN_CAP (1u << 18)

__device__ __forceinline__ unsigned xb_ld(unsigned* p)              { return __hip_atomic_load(p, __ATOMIC_RELAXED, __HIP_MEMORY_SCOPE_AGENT); }
__device__ __forceinline__ unsigned xb_add(unsigned* p, unsigned v) { return __hip_atomic_fetch_add(p, v, __ATOMIC_RELAXED, __HIP_MEMORY_SCOPE_AGENT); }
__device__ __forceinline__ unsigned xb_xcc_id() { return (unsigned)__builtin_amdgcn_s_getreg((3 << 11) | 20) & 0xFu; }
#define XB_SPIN(cond, bar) do { unsigned _sp = 0; while (cond) { __builtin_amdgcn_s_sleep(1); \
    if ((++_sp & 255u) == 0u) { if (xb_ld(&(bar)[XB_TMO])) break; if (_sp > XB_SPIN_CAP) { atomicAdd(&(bar)[XB_TMO], 1u); break; } } } } while (0)

struct XcdBarrier {
    unsigned* bar; unsigned x;
    volatile LAS unsigned* st;
};

__device__ __forceinline__ XcdBarrier xcd_barrier_post(unsigned* bar, volatile LAS unsigned* st) {
    XcdBarrier b; b.bar = bar; b.x = xb_xcc_id(); b.st = st;
    if (threadIdx.x == 0) (void)xb_add(&bar[XB_XCNT(b.x)], 1u);
    return b;
}
__device__ __forceinline__ void xcd_barrier_complete(unsigned* bar, unsigned x, unsigned& nloc, unsigned& nx) {
    const unsigned G = gridDim.x * gridDim.y * gridDim.z;
    unsigned sum, cnt, mine, sp = 0u;
    for (;;) {
        sum = 0u; cnt = 0u; mine = 0u;
#pragma unroll
        for (unsigned j = 0; j < 16; ++j) { const unsigned c = xb_ld(&bar[XB_XCNT(j)]); sum += c; cnt += (c > 0u) ? 1u : 0u; mine = (j == x) ? c : mine; }
        if (sum == G) break;
        __builtin_amdgcn_s_sleep(1);
        if ((++sp & 255u) == 0u) { if (xb_ld(&bar[XB_TMO])) break; if (sp > XB_SPIN_CAP) { atomicAdd(&bar[XB_TMO], 1u); break; } }
    }
    nloc = mine > 0u ? mine : 1u; nx = cnt > 0u ? cnt : 1u;
}

__device__ __forceinline__ void xcd_barrier(const XcdBarrier& b) {
    asm volatile("s_waitcnt vmcnt(0)" ::: "memory");
    __syncthreads();
    if (threadIdx.x == 0) {
        unsigned* bar = b.bar;
        __builtin_amdgcn_s_waitcnt(0);
        unsigned nloc = b.st[0], nx = b.st[1];
        if (nloc == 0u) { xcd_barrier_complete(bar, b.x, nloc, nx); b.st[0] = nloc; b.st[1] = nx; }
        const unsigned old = xb_add(&bar[XB_XSUB(b.x)], 1u);
        const unsigned gen = old / nloc;
        if (old + 1u == (gen + 1u) * nloc) {
            __builtin_amdgcn_fence(__ATOMIC_RELEASE, "agent");
            asm volatile("s_waitcnt vmcnt(0)" ::: "memory");
            const unsigned og = xb_add(&bar[XB_TOP], 1u);
            const unsigned tg = og / nx;
            if (og + 1u == (tg + 1u) * nx) xb_add(&bar[XB_TOPGEN], 1u);
            else XB_SPIN(xb_ld(&bar[XB_TOPGEN]) == tg, bar);
            __builtin_amdgcn_fence(__ATOMIC_ACQUIRE, "agent");
            xb_add(&bar[XB_XGEN(b.x)], 1u);
            asm volatile("s_waitcnt vmcnt(0)" ::: "memory");
        } else {
            XB_SPIN(xb_ld(&bar[XB_XGEN(b.x)]) == gen, bar);
            __builtin_amdgcn_fence(__ATOMIC_ACQUIRE, "agent");
            asm volatile("s_waitcnt vmcnt(0)" ::: "memory");
        }
    }
    __syncthreads();
}

#ifndef PROBE_SUB
#define PROBE_SUB 255
#endif
template <int K, int REP = 0>
DI void run_phase(const Params& p, const int l, unsigned char* lds) {
    int tid_ = threadIdx.x; asm volatile("" : "+v"(tid_));
    int bid_ = blockIdx.x; asm volatile("" : "+s"(bid_));
    const int tid = tid_, lane = tid & 63, wave = __builtin_amdgcn_readfirstlane(tid >> 6);
    const int G = gridDim.x, bid = bid_, gw = bid * 8 + wave, ngw = G * 8;
    const bool last = (l == 1);
    const int M = last ? T_LAT : T_ALL;
    const float* xl = l == 0 ? p.in[0] : p.out; const float* xc = l == 0 ? p.in[2] : (const float*)(p.ws + WS_XC);
    float* XC = (float*)(p.ws + WS_XC); const float* MOD = (const float*)(p.ws + WS_MOD);
    if constexpr (K == 0) { if (REP == 0 || (PROBE_SUB & 32)) ph_weights(p, l, lds, gw, ngw, wave, lane); __syncthreads(); if (REP == 0 || (PROBE_SUB & 64)) ph_ada_partial(p, l, lds, bid, G, tid); if (REP == 0 || (PROBE_SUB & 128)) ph_hyfilt(p, l, lds, bid, G, tid); }
    else if constexpr (K == 1) { ph_b(p, l, bid, G, tid, gw, ngw, lane); }
    else if constexpr (K == 2) { ph_norm(p, xl, xc, p.in[6] + l * 2048, 0, 1, T_ALL, gw, ngw, lane, (l == 1 && G == 256) ? 5 : -1); }
    else if constexpr (K == 3) {
        pg8::Gemm g{(const bf16_t*)(p.ws + WS_A), (const bf16_t*)(p.ws + WS_WIN), T_ALL, NINP, DM, 0}; pg8::StaticOrder S; S.init(T_ALL, NINP, G, bid);
        EpiStoreBf16 E{(bf16_t*)(p.ws + WS_PX), NINP, 0};
        pg8::gemm_phase<EpiStoreBf16, pg8::StaticOrder, true, true>((PG8_LAS unsigned char*)lds, g, S, E, tid);
    }
    else if constexpr (K == 4) { if (REP == 0 || (PROBE_SUB & 1)) ph_rw_prep(p, l, lds, bid, G, tid); if (REP == 0) ph_gd_prep(p, l, lds, bid, G, tid, lane, wave); if (REP == 0 || (PROBE_SUB & 2)) ph_rg_prep(p, l, lds, bid, G, tid); if (REP == 0 || (PROBE_SUB & 4)) ph_hy_prep(p, l, lds, bid, G, tid); }
    else if constexpr (K == 5) {
        if (bid < 128) {
            if (REP == 0 || (PROBE_SUB & 8)) rw_scan(p, l, (((bid & 7) + 8 * (bid >> 4)) << 1) | ((bid >> 3) & 1), lds, tid, lane, wave);
            if (REP == 0) {
                if (bid >= 64) rg_scan(p, bid - 64, lds, lane, wave);
                for (int c = bid; c < 256; c += 128) hy_conv_mfma(p, l, c, lds, tid);
                if (l == 0) for (int c = bid; c < 512; c += 128) hy_conv<256>(p, l, c, lds, tid); }
        }
        else { const int gi = bid - 128;
            if (REP == 0 || (PROBE_SUB & 16)) gd_scan(p, l, (((gi & 7) + 8 * (gi >> 5)) << 2) | ((gi >> 3) & 3), lds, tid, lane, wave);
            if (REP == 0) for (int c = 256 + (bid - 128); c < 512; c += 128) hy_conv_mfma(p, l, c, lds, tid); }
    }
    else if constexpr (K == 6) { ph_post(p, l, lds, gw, ngw, lane, wave, M); }
    else if constexpr (K == 7) {
        {
            pg8::Gemm g{(const bf16_t*)(p.ws + WS_A), (const bf16_t*)(p.ws + WS_WO), T_LAT, DM, DM, 0}; pg8::StaticOrder S; S.init(T_LAT, DM, G, bid);
            EpiResidual E{xl, xc, p.out, XC, MOD + 2 * 2048};
            pg8::gemm_phase<EpiResidual, pg8::StaticOrder, true, true>((PG8_LAS unsigned char*)lds, g, S, E, tid);
        }
        if (!last && G == 256) {
            const int ks = bid >> 5, u = bid & 31;
            pg8::Gemm g{(const bf16_t*)(p.ws + WS_A) + (size_t)T_LAT * DM + ks * 256, (const bf16_t*)(p.ws + WS_WO) + ks * 256, 1024, DM, 256, DM}; OneUnit S{u >> 3, u & 7};
            EpiSlab E{(float*)(p.ws + WS_PX) + (size_t)ks * 1024 * DM, MOD + 2 * 2048};
            pg8::gemm_phase<EpiSlab, OneUnit, false, true>((PG8_LAS unsigned char*)lds, g, S, E, tid);
        } else if (!last) {
            pg8::Gemm g{(const bf16_t*)(p.ws + WS_A) + (size_t)T_LAT * DM, (const bf16_t*)(p.ws + WS_WO), 1024, DM, DM, 0}; pg8::StaticOrder S; S.init(1024, DM, G, bid);
            EpiResidual E{xc, xc, XC, XC, MOD + 2 * 2048 + 4 * 12288};
            pg8::gemm_phase<EpiResidual, pg8::StaticOrder, true, true>((PG8_LAS unsigned char*)lds, g, S, E, tid);
        }
    }
    else if constexpr (K == 8) { ph_norm(p, p.out, (l == 0 && G == 256) ? p.in[2] : XC, p.in[7] + l * 2048, 3, 4, M, gw, ngw, lane, (l == 0 && G == 256) ? 2 : -1); }
    else if constexpr (K == 9) {
        pg8::Gemm g{(const bf16_t*)(p.ws + WS_A), (const bf16_t*)(p.ws + WS_W1), M, DFF, DM, 0}; pg8::StaticOrder S; S.init(M, DFF, G, bid);
        EpiStoreBf16 E{(bf16_t*)(p.ws + WS_H), DFF, 1};
        pg8::gemm_phase<EpiStoreBf16, pg8::StaticOrder, true, true>((PG8_LAS unsigned char*)lds, g, S, E, tid);
    }
    else if constexpr (K == 10) {
        {
            pg8::Gemm g{(const bf16_t*)(p.ws + WS_H), (const bf16_t*)(p.ws + WS_W2), T_LAT, DM, DFF, 0}; pg8::StaticOrder S; S.init(T_LAT, DM, G, bid);
            EpiResidual E{p.out, XC, p.out, XC, MOD + 5 * 2048};
            pg8::gemm_phase<EpiResidual, pg8::StaticOrder, true, true>((PG8_LAS unsigned char*)lds, g, S, E, tid);
        }
        if (!last && G == 256) {
            const int ks = bid >> 5, u = bid & 31;
            pg8::Gemm g{(const bf16_t*)(p.ws + WS_H) + (size_t)T_LAT * DFF + ks * 1024, (const bf16_t*)(p.ws + WS_W2) + ks * 1024, 1024, DM, 1024, DFF}; OneUnit S{u >> 3, u & 7};
            EpiSlab E{(float*)(p.ws + WS_PX) + (size_t)ks * 1024 * DM, MOD + 5 * 2048};
            pg8::gemm_phase<EpiSlab, OneUnit, false, true>((PG8_LAS unsigned char*)lds, g, S, E, tid);
        } else if (!last) {
            pg8::Gemm g{(const bf16_t*)(p.ws + WS_H) + (size_t)T_LAT * DFF, (const bf16_t*)(p.ws + WS_W2), 1024, DM, DFF, 0}; pg8::StaticOrder S; S.init(1024, DM, G, bid);
            EpiResidual E{XC, XC, XC, XC, MOD + 5 * 2048 + 4 * 12288};
            pg8::gemm_phase<EpiResidual, pg8::StaticOrder, true, true>((PG8_LAS unsigned char*)lds, g, S, E, tid);
        }
    }
    else { ph_final(p, gw, ngw, lane); }
}

#ifndef MK_FUSED
#define MK_FUSED 1
#endif
#if MK_FUSED
__global__ void __launch_bounds__(512) mk_fwd(Params p) {
    extern __shared__ __attribute__((aligned(16))) unsigned char lds[];
    cg::grid_group grid = cg::this_grid();
    if (threadIdx.x < 16) ((unsigned*)(lds + LDS_BYTES - 64))[threadIdx.x] = 0u;
    __syncthreads();
    const XcdBarrier xbar = xcd_barrier_post((unsigned*)(p.ws + WS_BAR), (volatile LAS unsigned*)((LAS unsigned char*)lds + (LDS_BYTES - 64)));
#define GSYNC() do { if (p.out == nullptr) grid.sync(); xcd_barrier(xbar); } while (0)
#ifndef PROBE_DUP
#define PROBE_DUP 0
#endif
#define PHS(K, L) run_phase<K>(p, L, lds); GSYNC(); if ((PROBE_DUP >> K) & 1) { if (!((K == 7 && L == 1) || K == 10)) { run_phase<K, 1>(p, L, lds); GSYNC(); } }
#define LAYER(L) PHS(0, L) PHS(1, L) PHS(2, L) PHS(3, L) PHS(4, L) PHS(5, L) PHS(6, L) PHS(7, L) PHS(8, L) PHS(9, L) PHS(10, L)
    LAYER(0) LAYER(1)
#ifdef PROBE_SYNCS
    for (int i = 0; i < PROBE_SYNCS; ++i) GSYNC();
#endif
    run_phase<11>(p, 1, lds);
}
#else
template <int K> __global__ void __launch_bounds__(512) k_phase(Params p, int l) {
    extern __shared__ __attribute__((aligned(16))) unsigned char lds[];
    run_phase<K>(p, l, lds);
}
template <int K> static void launch_phase(const Params& p, int l, int grid, hipStream_t stream) {
    static bool attr = false;
    if (!attr) { (void)hipFuncSetAttribute((const void*)k_phase<K>, hipFuncAttributeMaxDynamicSharedMemorySize, LDS_BYTES); attr = true; }
    hipLaunchKernelGGL(k_phase<K>, dim3(grid), dim3(512), LDS_BYTES, stream, p, l);
}
#endif

extern "C" void kernel_launch(void* const* d_in, const int* in_sizes, int n_in, void* d_out, int out_size, void* d_ws, size_t ws_size, hipStream_t stream) {
    static int grid_blocks = 0;
    if (grid_blocks == 0) {
        if (n_in != 43 || ws_size < WS_END) { fprintf(stderr, "kernel_launch: unexpected inputs (n_in %d, ws %zu < %zu)\n", n_in, ws_size, (size_t)WS_END); grid_blocks = -1; return; }
        int dev = 0, cus = 0, per_cu = 1;
        (void)hipGetDevice(&dev); (void)hipDeviceGetAttribute(&cus, hipDeviceAttributeMultiprocessorCount, dev);
#if MK_FUSED
        (void)hipFuncSetAttribute((const void*)mk_fwd, hipFuncAttributeMaxDynamicSharedMemorySize, LDS_BYTES);
        (void)hipOccupancyMaxActiveBlocksPerMultiprocessor(&per_cu, (const void*)mk_fwd, 512, LDS_BYTES);
        if (per_cu < 1) per_cu = 1;
#endif
        grid_blocks = cus * per_cu;
        if (grid_blocks > 256) grid_blocks = 256;
    }
    if (grid_blocks < 0) return;
    Params p{};
    for (int i = 0; i < 43; ++i) p.in[i] = (const float*)d_in[i];
    p.out = (float*)d_out; p.ws = (unsigned char*)d_ws;
#if MK_FUSED
    (void)hipMemsetAsync((unsigned char*)d_ws + WS_BAR, 0, 16384, stream);
    void* args[] = {&p};
    hipError_t e = hipLaunchCooperativeKernel((const void*)mk_fwd, dim3(grid_blocks), dim3(512), args, LDS_BYTES, stream);
    if (e != hipSuccess) fprintf(stderr, "cooperative launch failed: %s (grid %d)\n", hipGetErrorString(e), grid_blocks);
#else
    for (int l = 0; l < 2; ++l) {
        launch_phase<0>(p, l, grid_blocks, stream); launch_phase<1>(p, l, grid_blocks, stream); launch_phase<2>(p, l, grid_blocks, stream); launch_phase<3>(p, l, grid_blocks, stream);
        launch_phase<4>(p, l, grid_blocks, stream); launch_phase<5>(p, l, grid_blocks, stream); launch_phase<6>(p, l, grid_blocks, stream); launch_phase<7>(p, l, grid_blocks, stream);
        launch_phase<8>(p, l, grid_blocks, stream); launch_phase<9>(p, l, grid_blocks, stream); launch_phase<10>(p, l, grid_blocks, stream);
    }
    launch_phase<11>(p, 1, grid_blocks, stream);
#endif
}
```

```cpp
#include <hip/hip_runtime.h>
#include <hip/hip_cooperative_groups.h>
#include <cstdio>
#include <cstdint>
namespace cg = cooperative_groups;
namespace pg8 {
#define PG8_LAS __attribute__((address_space(3)))
typedef unsigned short bf16_t;
typedef short bf16x8 __attribute__((ext_vector_type(8)));
typedef float f32x4 __attribute__((ext_vector_type(4)));
typedef unsigned u32x4 __attribute__((ext_vector_type(4)));
constexpr int BM = 256, BK = 64, HALF = 128, HTB = HALF * BK * 2  , STAGE_BYTES = 8 * HTB, NXCD = 8, WGM = 8;

__host__ __device__ __forceinline__ int lds_byte(int r, int c) { const int st = (r >> 4) * 2 + (c >> 5), rr = r & 15, cc = c & 31, ob = rr * 64 + cc * 2; return st * 1024 + (ob ^ (((ob >> 9) & 1) << 5)); }
__host__ __device__ __forceinline__ void stage_rc(int b, int& R, int& C) { const int st = b / 1024, sb = b % 1024, swz = sb ^ (((sb >> 9) & 1) << 5); R = (st >> 1) * 16 + swz / 64; C = (st & 1) * 32 + (swz % 64) / 2; }
__host__ __device__ __forceinline__ int perm32(int rho) { const int n = rho >> 4, i = rho & 15; return 8 * (i >> 2) + 4 * n + (i & 3); }

struct Unit { int pm, pn; };
struct Gemm { const bf16_t* A; const bf16_t* Bt; int M, N, K, ld; };

struct StaticOrder {
    int nM, nN, nwg, G, c;
    __host__ __device__ void init(int M, int N, int G_, int c_) { nM = M / BM; nN = N / BM; nwg = nM * nN; G = G_; c = c_; }
    __host__ __device__ bool next(int i, Unit& u) const {
        const long L = (long)i * G + c; if (L >= nwg) return false;
        int wgid = (int)L; { const int q = nwg / NXCD, r = nwg % NXCD, xcd = wgid % NXCD, off = wgid / NXCD; wgid = (xcd < r ? xcd * (q + 1) : r * (q + 1) + (xcd - r) * q) + off; }
        const int nig = WGM * nN, gid = wgid / nig, fm = gid * WGM, gsz = (nM - fm) < WGM ? (nM - fm) : WGM;
        u.pm = fm + ((wgid % nig) % gsz); u.pn = (wgid % nig) / gsz; return true;
    }
    __device__ __forceinline__ void a_ready(const Unit&) const {}
    __device__ __forceinline__ void done(const Unit&) const {}
};

__device__ __forceinline__ unsigned cvt_pk_bf16(float lo, float hi) { unsigned r; asm volatile("v_cvt_pk_bf16_f32 %0, %1, %2" : "=v"(r) : "v"(lo), "v"(hi)); return r; }
typedef float f32x2 __attribute__((ext_vector_type(2)));
template <class Epi, class Sched, bool ALIGN_EPI = false, bool SP2 = false>
__device__ __forceinline__ void gemm_phase(PG8_LAS unsigned char* lds, const Gemm g, const Sched& S, const Epi& E, const int tid) {
    const int wid = __builtin_amdgcn_readfirstlane(tid >> 6), lane = tid & 63, wr = wid >> 2, wc = wid & 3, fr = lane & 15, fq = lane >> 4;
    const int nt = g.K / BK; const int K = g.ld ? g.ld : g.K;
    unsigned voffA[2], voffB[2];
#pragma unroll
    for (int i = 0; i < 2; ++i) { int R, C; stage_rc(tid * 16 + i * 8192, R, C); const int Rb = Epi::PERM ? ((R & ~31) + perm32(R & 31)) : R;
        voffA[i] = (unsigned)(R * K + C) * 2u; voffB[i] = (unsigned)(Rb * K + C) * 2u; }
    const size_t kstep = (size_t)(BK * 2);
    const size_t hstep = (size_t)HALF * K * 2;
    const size_t tstep = 2 * hstep;
    const unsigned ldsw = (unsigned)wid * 1024u;
    const int aoff = lds_byte(wr * 64 + fr, fq * 8), boff = lds_byte(wc * 32 + fr, fq * 8);
#define PG8_SA(b, h) (((b) * 2 + (h)) * HTB)
#define PG8_SB(b, h) ((4 + (b) * 2 + (h)) * HTB)
#define PG8_STAGE(bufoff, gbase, voff) do { _Pragma("unroll") for (int _i = 0; _i < 2; ++_i) \
        __builtin_amdgcn_global_load_lds((const unsigned*)((const char*)(gbase) + (voff)[_i]), (PG8_LAS unsigned*)(lds + (bufoff) + ldsw + _i * 8192), 16, 0, 0); } while (0)
#define PG8_LDA(dst, b, h) do { _Pragma("unroll") for (int m = 0; m < 4; ++m) _Pragma("unroll") for (int k = 0; k < 2; ++k) dst[m][k] = *(const PG8_LAS bf16x8*)(lds + PG8_SA(b, h) + aoff + m * 2048 + k * 1024); } while (0)
#define PG8_LDB(dst, b, h) do { _Pragma("unroll") for (int n = 0; n < 2; ++n) _Pragma("unroll") for (int k = 0; k < 2; ++k) dst[n][k] = *(const PG8_LAS bf16x8*)(lds + PG8_SB(b, h) + boff + n * 2048 + k * 1024); } while (0)
#define PG8_MMA(ai, bj, At, Bt) do { __builtin_amdgcn_s_setprio(1); _Pragma("unroll") for (int m = 0; m < 4; ++m) _Pragma("unroll") for (int n = 0; n < 2; ++n) _Pragma("unroll") for (int k = 0; k < 2; ++k) \
        acc[ai][bj][m][n] = __builtin_amdgcn_mfma_f32_16x16x32_bf16(Bt[n][k], At[m][k], acc[ai][bj][m][n], 0, 0, 0); __builtin_amdgcn_s_setprio(0); } while (0)
#define PG8_WAIT_V(n) asm volatile("s_waitcnt vmcnt(" #n ")" ::: "memory")
#define PG8_WAIT_L(n) asm volatile("s_waitcnt lgkmcnt(" #n ")" ::: "memory")
#define PG8_BAR __builtin_amdgcn_s_barrier()
#define PG8_SCHED __builtin_amdgcn_sched_barrier(0)
    Unit cur, nxt; int ui = 0;
    if (!S.next(0, cur)) return;
    f32x4 acc[2][2][4][2];
#pragma unroll
    for (int a = 0; a < 2; ++a)
#pragma unroll
        for (int b = 0; b < 2; ++b)
#pragma unroll
            for (int m = 0; m < 4; ++m)
#pragma unroll
                for (int n = 0; n < 2; ++n) acc[a][b][m][n] = (f32x4){0.f, 0.f, 0.f, 0.f};
    bf16x8 At[4][2], B0[2][2], B1[2][2];
    const char* cA = (const char*)g.A + (size_t)cur.pm * tstep; const char* cB = (const char*)g.Bt + (size_t)cur.pn * tstep;
    S.a_ready(cur);
    if constexpr (SP2) {
        PG8_STAGE(PG8_SB(0, 0), cB, voffB); PG8_STAGE(PG8_SB(0, 1), cB + hstep, voffB); PG8_STAGE(PG8_SA(0, 0), cA, voffA); PG8_STAGE(PG8_SA(0, 1), cA + hstep, voffA);
        if (wr == 1) PG8_BAR;
        PG8_WAIT_V(2); PG8_BAR;
        PG8_STAGE(PG8_SB(1, 0), cB + kstep, voffB); PG8_STAGE(PG8_SA(1, 0), cA + kstep, voffA); PG8_STAGE(PG8_SB(1, 1), cB + hstep + kstep, voffB);
        PG8_WAIT_V(6); PG8_BAR;
    } else {
        PG8_STAGE(PG8_SB(0, 0), cB, voffB); PG8_STAGE(PG8_SA(0, 0), cA, voffA); PG8_STAGE(PG8_SB(0, 1), cB + hstep, voffB); PG8_STAGE(PG8_SA(0, 1), cA + hstep, voffA);
        if (wr == 1) PG8_BAR;
        PG8_WAIT_V(4); PG8_BAR;
        PG8_STAGE(PG8_SB(1, 0), cB + kstep, voffB); PG8_STAGE(PG8_SA(1, 0), cA + kstep, voffA); PG8_STAGE(PG8_SB(1, 1), cB + hstep + kstep, voffB);
        PG8_WAIT_V(6); PG8_BAR;
    }
    for (;;) {
        const bool has_next = S.next(ui + 1, nxt);
        const char* nA = has_next ? (const char*)g.A + (size_t)nxt.pm * tstep : cA; const char* nB = has_next ? (const char*)g.Bt + (size_t)nxt.pn * tstep : cB;
        for (int t = 0; t < nt; t += 2) {
            const bool last = (t == nt - 2);
            const char* a1 = cA + (size_t)(t + 1) * kstep;
            const char* a2 = last ? nA : cA + (size_t)(t + 2) * kstep; const char* b2 = last ? nB : cB + (size_t)(t + 2) * kstep;
            const char* a3 = a2 + kstep; const char* b3 = b2 + kstep;
            if (last && has_next) S.a_ready(nxt);
            if constexpr (SP2) {
            PG8_LDB(B0, 0, 0); PG8_LDB(B1, 0, 1); PG8_SCHED; PG8_LDA(At, 0, 0); PG8_STAGE(PG8_SA(1, 1), a1 + hstep, voffA);
            PG8_WAIT_V(8); PG8_WAIT_L(0); PG8_BAR; PG8_MMA(0, 0, At, B0); PG8_MMA(0, 1, At, B1); PG8_BAR; PG8_SCHED;
            PG8_LDA(At, 0, 1); PG8_STAGE(PG8_SB(0, 0), b2, voffB); PG8_STAGE(PG8_SB(0, 1), b2 + hstep, voffB); PG8_STAGE(PG8_SA(0, 0), a2, voffA);
            PG8_WAIT_V(8); PG8_WAIT_L(0); PG8_BAR; PG8_MMA(1, 0, At, B0); PG8_MMA(1, 1, At, B1); PG8_BAR; PG8_SCHED;
            PG8_LDB(B0, 1, 0); PG8_LDB(B1, 1, 1); PG8_SCHED; PG8_LDA(At, 1, 0); PG8_STAGE(PG8_SA(0, 1), a2 + hstep, voffA);
            PG8_WAIT_V(8); PG8_WAIT_L(0); PG8_BAR; PG8_MMA(0, 0, At, B0); PG8_MMA(0, 1, At, B1); PG8_BAR; PG8_SCHED;
            PG8_LDA(At, 1, 1); PG8_STAGE(PG8_SB(1, 0), b3, voffB); PG8_STAGE(PG8_SB(1, 1), b3 + hstep, voffB); PG8_STAGE(PG8_SA(1, 0), a3, voffA);
            PG8_WAIT_V(8); PG8_WAIT_L(0); PG8_BAR; PG8_MMA(1, 0, At, B0); PG8_MMA(1, 1, At, B1); PG8_BAR; PG8_SCHED;
            } else {
            PG8_LDB(B0, 0, 0); PG8_SCHED; PG8_LDA(At, 0, 0); PG8_STAGE(PG8_SA(1, 1), a1 + hstep, voffA);
            PG8_WAIT_L(8); PG8_BAR; PG8_WAIT_L(0); PG8_MMA(0, 0, At, B0); PG8_BAR; PG8_SCHED;
            PG8_LDB(B1, 0, 1); PG8_STAGE(PG8_SB(0, 0), b2, voffB);
            PG8_BAR; PG8_WAIT_L(0); PG8_MMA(0, 1, At, B1); PG8_BAR;
            PG8_LDA(At, 0, 1); PG8_STAGE(PG8_SA(0, 0), a2, voffA);
            PG8_BAR; PG8_WAIT_L(0); PG8_MMA(1, 0, At, B0); PG8_BAR; PG8_SCHED;
            PG8_STAGE(PG8_SB(0, 1), b2 + hstep, voffB);
            PG8_WAIT_V(6); PG8_BAR; PG8_MMA(1, 1, At, B1); PG8_BAR;
            PG8_LDB(B0, 1, 0); PG8_SCHED; PG8_LDA(At, 1, 0); PG8_STAGE(PG8_SA(0, 1), a2 + hstep, voffA);
            PG8_WAIT_L(8); PG8_BAR; PG8_WAIT_L(0); PG8_MMA(0, 0, At, B0); PG8_BAR; PG8_SCHED;
            PG8_LDB(B1, 1, 1); PG8_STAGE(PG8_SB(1, 0), b3, voffB);
            PG8_BAR; PG8_WAIT_L(0); PG8_MMA(0, 1, At, B1); PG8_BAR;
            PG8_LDA(At, 1, 1); PG8_STAGE(PG8_SA(1, 0), a3, voffA);
            PG8_BAR; PG8_WAIT_L(0); PG8_MMA(1, 0, At, B0); PG8_BAR; PG8_SCHED;
            PG8_STAGE(PG8_SB(1, 1), b3 + hstep, voffB);
            PG8_WAIT_V(6); PG8_BAR; PG8_MMA(1, 1, At, B1); PG8_BAR;
            }
        }
        if constexpr (ALIGN_EPI) { if (wr == 0) PG8_BAR; }
        if constexpr (!Epi::AFTER_DRAIN) { E(acc, cur, wr, wc, fr, fq); S.done(cur); }
        if (!has_next) break;
#pragma unroll
        for (int a = 0; a < 2; ++a)
#pragma unroll
            for (int b = 0; b < 2; ++b)
#pragma unroll
                for (int m = 0; m < 4; ++m)
#pragma unroll
                    for (int n = 0; n < 2; ++n) acc[a][b][m][n] = (f32x4){0.f, 0.f, 0.f, 0.f};
        cur = nxt; cA = nA; cB = nB; ++ui;
        if constexpr (ALIGN_EPI) { if (wr == 1) PG8_BAR; }
    }
    PG8_WAIT_V(0);
    if constexpr (!ALIGN_EPI) { if (wr == 0) PG8_BAR; }
    PG8_BAR;
    if constexpr (Epi::AFTER_DRAIN) { E.fused(acc, cur, wr, wc, fr, fq, lds, wid, lane); S.done(cur); }
#undef PG8_SA
#undef PG8_SB
#undef PG8_STAGE
#undef PG8_LDA
#undef PG8_LDB
#undef PG8_MMA
#undef PG8_WAIT_V
#undef PG8_WAIT_L
#undef PG8_BAR
#undef PG8_SCHED
}
}

#define DI __device__ __forceinline__
typedef unsigned short bf16_t;
typedef float f32x4 __attribute__((ext_vector_type(4)));
typedef unsigned u32x4 __attribute__((ext_vector_type(4)));
typedef unsigned u32x2 __attribute__((ext_vector_type(2)));

constexpr int T_ALL = 17408, T_LAT = 16384, DM = 2048, NIN = 6416, NINP = 6656, DFF = 8192;
constexpr int HYO = 0, RWO = 1536, GDO = 3328, RGO = 5392;
constexpr int LDS_BYTES = 147456;
constexpr int NPH_LAYER = 11, NPH = 2 * NPH_LAYER + 1;

constexpr size_t al256(size_t x) { return (x + 255) & ~(size_t)255; }
constexpr size_t WS_MOD = 0;
constexpr size_t WS_PART = al256(WS_MOD + (size_t)5 * 12288 * 4);
constexpr size_t WS_HGL = al256(WS_PART + (size_t)32 * 5 * 12288 * 4);
constexpr size_t WS_HGC = al256(WS_HGL + (size_t)2 * 512 * 4096 * 4);
constexpr size_t WS_INORM = al256(WS_HGC + (size_t)2 * 512 * 256 * 4);
constexpr size_t WS_XC = al256(WS_INORM + 1024 * 4);
constexpr size_t WS_A = al256(WS_XC + (size_t)1024 * 2048 * 4);
constexpr size_t WS_PX = al256(WS_A + (size_t)T_ALL * 2048 * 2);
constexpr size_t WS_WO = al256(WS_PX + (size_t)T_ALL * NINP * 2);
constexpr size_t WS_W1 = al256(WS_WO + (size_t)2048 * 2048 * 2);
constexpr size_t WS_W2 = al256(WS_W1 + (size_t)8192 * 2048 * 2);
constexpr size_t WS_WIN = al256(WS_W2 + (size_t)2048 * 8192 * 2);
constexpr size_t WS_H = al256(WS_WIN + (size_t)NINP * 2048 * 2);
constexpr size_t WS_LW = al256(WS_H + (size_t)T_ALL * 8192 * 2);
constexpr size_t WS_RGW = WS_LW + 2 * 262144;
constexpr size_t WS_BAR = WS_RGW + 16 * 32768;
constexpr size_t WS_END = WS_BAR + 16384;
constexpr size_t MSU = (size_t)T_ALL * 512 * 2;

struct Params { const float* in[43]; float* out; unsigned char* ws; };

DI float bf2f(bf16_t v) { return __uint_as_float((unsigned)v << 16); }
DI bf16_t f2bf(float f) { unsigned u = __float_as_uint(f); return (bf16_t)((u + 0x7fffu + ((u >> 16) & 1u)) >> 16); }
DI unsigned pk2(float lo, float hi) { return (unsigned)f2bf(lo) | ((unsigned)f2bf(hi) << 16); }
DI float bflo(unsigned w) { return __uint_as_float(w << 16); }
DI float bfhi(unsigned w) { return __uint_as_float(w & 0xffff0000u); }
DI float wave_sum(float v) {
#pragma unroll
    for (int o = 1; o < 64; o <<= 1) v += __shfl_xor(v, o);
    return v;
}
#define DPPF(v, ctrl) __builtin_bit_cast(float, __builtin_amdgcn_mov_dpp(__builtin_bit_cast(int, (v)), (ctrl), 0xF, 0xF, true))
DI float wave_sum_fast(float v) {
    v += DPPF(v, 0xB1); v += DPPF(v, 0x4E); v += DPPF(v, 0x141); v += DPPF(v, 0x140);
    const int iv = __builtin_bit_cast(int, v);
    return (__builtin_bit_cast(float, __builtin_amdgcn_readlane(iv, 0)) + __builtin_bit_cast(float, __builtin_amdgcn_readlane(iv, 16))) +
           (__builtin_bit_cast(float, __builtin_amdgcn_readlane(iv, 32)) + __builtin_bit_cast(float, __builtin_amdgcn_readlane(iv, 48)));
}
DI float sigm(float x) { return __builtin_amdgcn_rcpf(1.f + __expf(-x)); }
DI float siluf(float x) { return x * __builtin_amdgcn_rcpf(1.f + __expf(-x)); }
DI float tanh_fast(float x) { return 1.f - 2.f * __builtin_amdgcn_rcpf(1.f + __expf(2.f * x)); }
DI float softplusf(float x) { return fmaxf(x, 0.f) + __logf(1.f + __expf(-fabsf(x))); }
DI float gelu_tanh(float x) { return 0.5f * x * (1.f + tanh_fast(0.7978845608f * (x + 0.044715f * x * x * x))); }
#define LDSW() asm volatile("s_waitcnt lgkmcnt(0)" ::: "memory")
#define LDS_BARRIER() do { asm volatile("s_waitcnt lgkmcnt(0)" ::: "memory"); __builtin_amdgcn_s_barrier(); asm volatile("" ::: "memory"); } while (0)

DI int scan_row(int n, int d, int b, bool& first) {
    if (n < 256) { const int tp = d ? 255 - n : n; first = (n == 0); return T_LAT + b * 256 + tp; }
    const int m = n - 256; const int tp = d ? 4095 - m : m; first = (m == 0); return b * 4096 + tp;
}

struct EpiStoreBf16 {
    static constexpr bool PERM = true, AFTER_DRAIN = false;
    bf16_t* O; int ldc; int act;
    DI void operator()(const pg8::f32x4 (&acc)[2][2][4][2], const pg8::Unit& u, int wr, int wc, int fr, int fq) const {
        const int row0 = u.pm * 256 + wr * 64 + fr, col0 = u.pn * 256 + wc * 32 + 8 * fq;
#pragma unroll
        for (int ai = 0; ai < 2; ++ai)
#pragma unroll
            for (int m = 0; m < 4; ++m) { bf16_t* rowp = O + (size_t)(row0 + ai * 128 + m * 16) * ldc + col0;
#pragma unroll
                for (int bj = 0; bj < 2; ++bj) { f32x4 v0 = acc[ai][bj][m][0], v1 = acc[ai][bj][m][1];
                    if (act) {
#pragma unroll
                        for (int e = 0; e < 4; ++e) { const float a = fmaxf(v0[e], 0.f), b = fmaxf(v1[e], 0.f); v0[e] = a * a; v1[e] = b * b; } }
                    u32x4 w; w.x = pg8::cvt_pk_bf16(v0[0], v0[1]); w.y = pg8::cvt_pk_bf16(v0[2], v0[3]); w.z = pg8::cvt_pk_bf16(v1[0], v1[1]); w.w = pg8::cvt_pk_bf16(v1[2], v1[3]);
                    *(u32x4*)(rowp + bj * 128) = w; } }
    }
};
struct EpiResidual {
    static constexpr bool PERM = false, AFTER_DRAIN = false;
    const float* baseL; const float* baseC; float* outL; float* outC; const float* gate;
    DI void operator()(const pg8::f32x4 (&acc)[2][2][4][2], const pg8::Unit& u, int wr, int wc, int fr, int fq) const {
        const bool isc = u.pm >= 64; const int bi = isc ? 4 : (u.pm >> 4);
        const int rloc = (isc ? (u.pm - 64) : u.pm) * 256 + wr * 64 + fr;
        const float* base = isc ? baseC : baseL; float* out = isc ? outC : outL;
        const int col0 = u.pn * 256 + wc * 32 + 4 * fq;
        const float* gp = gate + (size_t)bi * 12288 + col0;
        f32x4 g4[2][2];
#pragma unroll
        for (int bj = 0; bj < 2; ++bj)
#pragma unroll
            for (int n = 0; n < 2; ++n) g4[bj][n] = *(const f32x4*)(gp + bj * 128 + n * 16);
#pragma unroll
        for (int ai = 0; ai < 2; ++ai)
#pragma unroll
            for (int m = 0; m < 4; ++m) { const size_t off = (size_t)(rloc + ai * 128 + m * 16) * DM + col0;
#pragma unroll
                for (int bj = 0; bj < 2; ++bj)
#pragma unroll
                    for (int n = 0; n < 2; ++n) { const f32x4 bs = *(const f32x4*)(base + off + bj * 128 + n * 16);
                        *(f32x4*)(out + off + bj * 128 + n * 16) = bs + g4[bj][n] * acc[ai][bj][m][n]; }
                asm volatile("" ::: "memory"); }
    }
};

struct OneUnit {
    int pm, pn;
    DI bool next(int i, pg8::Unit& u) const { if (i != 0) return false; u.pm = pm; u.pn = pn; return true; }
    DI void a_ready(const pg8::Unit&) const {}
    DI void done(const pg8::Unit&) const {}
};
struct EpiSlab {
    static constexpr bool PERM = false, AFTER_DRAIN = false;
    float* slab; const float* gate;
    DI void operator()(const pg8::f32x4 (&acc)[2][2][4][2], const pg8::Unit& u, int wr, int wc, int fr, int fq) const {
        const int rloc = u.pm * 256 + wr * 64 + fr, col0 = u.pn * 256 + wc * 32 + 4 * fq;
        const float* gp = gate + (size_t)4 * 12288 + col0;
        f32x4 g4[2][2];
#pragma unroll
        for (int bj = 0; bj < 2; ++bj)
#pragma unroll
            for (int n = 0; n < 2; ++n) g4[bj][n] = *(const f32x4*)(gp + bj * 128 + n * 16);
#pragma unroll
        for (int ai = 0; ai < 2; ++ai)
#pragma unroll
            for (int m = 0; m < 4; ++m) { float* o = slab + (size_t)(rloc + ai * 128 + m * 16) * DM + col0;
#pragma unroll
                for (int bj = 0; bj < 2; ++bj)
#pragma unroll
                    for (int n = 0; n < 2; ++n) *(f32x4*)(o + bj * 128 + n * 16) = g4[bj][n] * acc[ai][bj][m][n]; }
    }
};

DI void tr_item(const float* W, int K, int N, int Npad, bf16_t* WT, float* scr, int item, int lane) {
    const int nblk = Npad / 32, kb = item / nblk, nb = item % nblk, k0 = 64 * kb, n0 = 32 * nb;
    const int n = n0 + (lane & 31);
    float tv[32];
#pragma unroll
    for (int i = 0; i < 32; ++i) { const int kk = 2 * i + (lane >> 5); tv[i] = (n < N) ? W[(size_t)(k0 + kk) * N + n] : 0.f; }
#pragma unroll
    for (int i = 0; i < 32; ++i) { const int kk = 2 * i + (lane >> 5); scr[kk * 33 + (lane & 31)] = tv[i]; }
    LDSW();
    const int c = lane & 7;
#pragma unroll
    for (int j = 0; j < 4; ++j) { const int nn = (lane >> 3) + 8 * j; const float* s = scr + (8 * c) * 33 + nn;
        u32x4 o; o.x = pk2(s[0 * 33], s[1 * 33]); o.y = pk2(s[2 * 33], s[3 * 33]); o.z = pk2(s[4 * 33], s[5 * 33]); o.w = pk2(s[6 * 33], s[7 * 33]);
        *(u32x4*)(WT + (size_t)(n0 + nn) * K + k0 + 8 * c) = o; }
    LDSW();
}

DI void ph_weights(const Params& p, int l, unsigned char* lds, int gw, int ngw, int wave, int lane) {
    float* scr = (float*)(lds + wave * 8448);
    const float* win = p.in[8] + (size_t)l * 2048 * NIN; const float* wo = p.in[9] + (size_t)l * 2048 * 2048;
    const float* w1 = p.in[40] + (size_t)l * 2048 * 8192; const float* w2 = p.in[41] + (size_t)l * 8192 * 2048;
    bf16_t* WinT = (bf16_t*)(p.ws + WS_WIN); bf16_t* WoT = (bf16_t*)(p.ws + WS_WO); bf16_t* W1T = (bf16_t*)(p.ws + WS_W1); bf16_t* W2T = (bf16_t*)(p.ws + WS_W2);
    constexpr int I_IN = 32 * (NINP / 32), I_O = 32 * 64, I_1 = 32 * 256, I_2 = 128 * 64;
    for (int it = gw; it < I_IN + I_O + I_1 + I_2 + 256; it += ngw) {
        int r = it;
        if (r < I_IN) { tr_item(win, 2048, NIN, NINP, WinT, scr, r, lane); continue; } r -= I_IN;
        if (r < I_O) { tr_item(wo, 2048, 2048, 2048, WoT, scr, r, lane); continue; } r -= I_O;
        if (r < I_1) { tr_item(w1, 2048, 8192, 8192, W1T, scr, r, lane); continue; } r -= I_1;
        if (r < I_2) { tr_item(w2, 8192, 2048, 2048, W2T, scr, r, lane); continue; } r -= I_2;
        if (r < 128) { const int d = r >> 6, q = r & 63; bf16_t* base = (bf16_t*)(p.ws + WS_LW) + (size_t)d * 131072;
            if (q < 16) tr_item(p.in[20] + (size_t)(l * 2 + d) * 64 * 512, 64, 512, 512, base, scr, q, lane);
            else if (q < 32) tr_item(p.in[22] + (size_t)(l * 2 + d) * 64 * 512, 64, 512, 512, base + 32768, scr, q - 16, lane);
            else tr_item(p.in[23] + (size_t)(l * 2 + d) * 128 * 512, 128, 512, 512, base + 65536, scr, q - 32, lane);
            continue; } r -= 128;
        { const int mat = r >> 3, q = r & 7; const int d = mat >> 3, gate = (mat >> 2) & 1, n = mat & 3;
          const float* src = (gate ? p.in[37] : p.in[35]) + ((size_t)((l * 2 + d) * 4 + n) * 128) * 128;
          tr_item(src, 128, 128, 128, (bf16_t*)(p.ws + WS_RGW) + (size_t)mat * 16384, scr, q, lane); }
    }
}

DI void ph_ada_partial(const Params& p, int l, unsigned char* lds, int bid, int G, int tid) {
    float* sl = (float*)lds;
    const float* aw = p.in[4] + (size_t)l * 2048 * 12288;
    float* PART = (float*)(p.ws + WS_PART);
    for (int it = bid; it < 24 * 32; it += G) {
        const int cb = it % 24, kc = it / 24;
        __syncthreads();
        if (tid < 320) { const int i = tid >> 6, kk = tid & 63; const float c = i < 4 ? p.in[1][i * 2048 + kc * 64 + kk] : p.in[3][kc * 64 + kk]; sl[tid] = siluf(c); }
        __syncthreads();
        const int col = cb * 512 + tid; float acc[5] = {0.f, 0.f, 0.f, 0.f, 0.f};
        const float* wp = aw + (size_t)(kc * 64) * 12288 + col;
#pragma unroll 32
        for (int kk = 0; kk < 64; ++kk) { const float w = wp[(size_t)kk * 12288];
#pragma unroll
            for (int i = 0; i < 5; ++i) acc[i] += sl[i * 64 + kk] * w; }
#pragma unroll
        for (int i = 0; i < 5; ++i) PART[((size_t)kc * 5 + i) * 12288 + col] = acc[i];
    }
    __syncthreads();
}

DI void ph_hyfilt(const Params& p, int l, unsigned char* lds, int bid, int G, int tid) {
    float* feat = (float*)lds;
    float* h1 = feat + 16 * 33;
    float* h2T = h1 + 16 * 64;
    float* w1s = h2T + 64 * 16;
    float* w2s = w1s + 33 * 64;
    const float* b1 = p.in[12] + l * 64; const float* b2 = p.in[14] + l * 64;
    const float* w3 = p.in[15] + (size_t)l * 64 * 1024; const float* fq = p.in[16] + l * 128;
    const int nitems = (l == 0) ? 256 + 16 : 256;
    __syncthreads();
    for (int idx = tid; idx < 33 * 64; idx += 512) w1s[idx] = p.in[11][(size_t)l * 33 * 64 + idx];
    for (int idx = tid; idx < 64 * 64; idx += 512) w2s[idx] = p.in[13][(size_t)l * 64 * 64 + idx];
    for (int it = (bid + 128) % G; it < nitems; it += G) {
        const int L = it < 256 ? 4096 : 256; const int t0 = (it < 256 ? it : it - 256) * 16;
        float* HG = (float*)(p.ws + (it < 256 ? WS_HGL : WS_HGC));
        const float invLm1 = 1.f / (float)(L - 1);
        __syncthreads();
        for (int idx = tid; idx < 16 * 33; idx += 512) { const int tt = idx / 33, f = idx % 33; const float t = (float)(t0 + tt); float val;
            if (f == 0) val = t * invLm1;
            else { const int i = (f - 1) & 15; const float band = 1e-4f + (float)i * ((15.f - 1e-4f) / 15.f); const float ang = (6.283185307179586f / (float)L) * t * band; val = (f <= 16) ? cosf(ang) : -sinf(ang); }
            feat[idx] = val; }
        __syncthreads();
        for (int o = tid; o < 1024; o += 512) { const int tt = o >> 6, j = o & 63; float acc = 0.f;
#pragma unroll
            for (int f = 0; f < 33; ++f) acc += feat[tt * 33 + f] * w1s[f * 64 + j];
            h1[tt * 64 + j] = sinf(fq[j] * (acc + b1[j])); }
        __syncthreads();
        for (int o = tid; o < 1024; o += 512) { const int tt = o >> 6, j = o & 63; float acc = 0.f;
#pragma unroll 16
            for (int i = 0; i < 64; ++i) acc += h1[tt * 64 + i] * w2s[i * 64 + j];
            h2T[j * 16 + tt] = sinf(fq[64 + j] * (acc + b2[j])); }
        __syncthreads();
        float accA[16], accB[16];
#pragma unroll
        for (int tt = 0; tt < 16; ++tt) { accA[tt] = 0.f; accB[tt] = 0.f; }
#pragma unroll 8
        for (int i = 0; i < 64; ++i) { const float wa = w3[i * 1024 + tid], wb = w3[i * 1024 + 512 + tid];
#pragma unroll
            for (int q = 0; q < 4; ++q) { const f32x4 hv = *(const f32x4*)(h2T + i * 16 + 4 * q);
#pragma unroll
                for (int e = 0; e < 4; ++e) { accA[4 * q + e] += hv[e] * wa; accB[4 * q + e] += hv[e] * wb; } } }
        const float delta = 3.0701134573253944f + (float)tid * (12.280453829301578f / 511.f);
        float* dA = HG + (size_t)tid * L + t0; float* dB = HG + (size_t)(512 + tid) * L + t0;
#pragma unroll
        for (int q = 0; q < 4; ++q) { f32x4 oa, ob;
#pragma unroll
            for (int e = 0; e < 4; ++e) { const float z = (float)(t0 + 4 * q + e) * invLm1; const float dec = expf(-z * delta); oa[e] = accA[4 * q + e] * dec; ob[e] = accB[4 * q + e] * dec; }
            *(f32x4*)(dA + 4 * q) = oa; *(f32x4*)(dB + 4 * q) = ob; }
    }
    __syncthreads();
}

DI void ph_b(const Params& p, int l, int bid, int G, int tid, int gw, int ngw, int lane) {
    const float* PART = (const float*)(p.ws + WS_PART); float* MOD = (float*)(p.ws + WS_MOD);
    const float* ab = p.in[5] + (size_t)l * 12288;
    for (int idx = bid * 512 + tid; idx < 5 * 12288; idx += G * 512) { const int i = idx / 12288, col = idx % 12288; float s = ab[col];
#pragma unroll
        for (int kc = 0; kc < 32; ++kc) s += PART[((size_t)kc * 5 + i) * 12288 + col];
        MOD[idx] = s; }
    float* INORM = (float*)(p.ws + WS_INORM);
    const int nit = (l == 0) ? 1024 : 512;
    for (int it = gw; it < nit; it += ngw) { const int c = it & 511; const int L = it < 512 ? 4096 : 256;
        const float* HG = (const float*)(p.ws + (it < 512 ? WS_HGL : WS_HGC));
        const float* gf = HG + (size_t)c * L; const float* gb = HG + (size_t)(512 + c) * L; float s = 0.f;
        for (int t = lane; t < L; t += 64) s += fabsf(gf[t]) + (t > 0 ? fabsf(gb[t]) : 0.f);
        s = wave_sum(s);
        if (lane == 0) INORM[it] = 1.f / s; }
}

DI void ph_norm(const Params& p, const float* xl, const float* xc, const float* g, int sh_idx, int sc_idx, int M, int gw, int ngw, int lane, int comb_gate) {
    const float* MOD = (const float*)(p.ws + WS_MOD); bf16_t* A = (bf16_t*)(p.ws + WS_A);
    f32x4 gs[8], hh[8];
#define NORM_PARAMS(bi_) do { const float* sh_ = MOD + (size_t)(bi_) * 12288 + sh_idx * 2048 + 4 * lane; const float* sc_ = MOD + (size_t)(bi_) * 12288 + sc_idx * 2048 + 4 * lane; \
        _Pragma("unroll") for (int j = 0; j < 8; ++j) { gs[j] = *(const f32x4*)(g + 4 * lane + 256 * j) * (*(const f32x4*)(sc_ + 256 * j) + 1.f); hh[j] = *(const f32x4*)(sh_ + 256 * j); } } while (0)
#define NORM_EMIT(v_, r_) do { float ss_ = 0.f; _Pragma("unroll") for (int j = 0; j < 8; ++j) ss_ += (v_[j][0] * v_[j][0] + v_[j][1] * v_[j][1]) + (v_[j][2] * v_[j][2] + v_[j][3] * v_[j][3]); \
        ss_ = wave_sum_fast(ss_); const float rs_ = rsqrtf(ss_ * (1.f / 2048.f) + 1e-6f); \
        _Pragma("unroll") for (int j = 0; j < 8; ++j) { const f32x4 y_ = (v_[j] * rs_) * gs[j] + hh[j]; u32x2 w_; w_.x = pk2(y_[0], y_[1]); w_.y = pk2(y_[2], y_[3]); \
            *(u32x2*)(A + (size_t)(r_) * DM + 4 * lane + 256 * j) = w_; } } while (0)
    const int nrow = (T_LAT + ngw - 1) / ngw; const int r0 = gw * nrow, r1 = (r0 + nrow < T_LAT) ? r0 + nrow : T_LAT;
    if (r0 < r1) {
        int bi = r0 >> 12; NORM_PARAMS(bi);
        f32x4 v[8], vn[8];
#pragma unroll
        for (int j = 0; j < 8; ++j) v[j] = *(const f32x4*)(xl + (size_t)r0 * DM + 4 * lane + 256 * j);
        for (int r = r0; r < r1; ++r) {
            const int rn = (r + 1 < r1) ? r + 1 : r;
#pragma unroll
            for (int j = 0; j < 8; ++j) vn[j] = *(const f32x4*)(xl + (size_t)rn * DM + 4 * lane + 256 * j);
            if ((r >> 12) != bi) { bi = r >> 12; NORM_PARAMS(bi); }
            NORM_EMIT(v, r);
#pragma unroll
            for (int j = 0; j < 8; ++j) v[j] = vn[j];
        }
    }
    if (M > T_LAT) {
        NORM_PARAMS(4);
        for (int r = T_LAT + gw; r < M; r += ngw) {
            const float* src = xc + (size_t)(r - T_LAT) * DM; f32x4 v[8];
#pragma unroll
            for (int j = 0; j < 8; ++j) v[j] = *(const f32x4*)(src + 4 * lane + 256 * j);
            if (comb_gate >= 0) {
                const float* sl = (const float*)(p.ws + WS_PX) + (size_t)(r - T_LAT) * DM + 4 * lane;
#pragma unroll
                for (int j = 0; j < 8; ++j) { f32x4 a = *(const f32x4*)(sl + 256 * j);
#pragma unroll
                    for (int ks = 1; ks < 8; ++ks) a += *(const f32x4*)(sl + (size_t)ks * 1024 * DM + 256 * j);
                    v[j] += a;
                    *(f32x4*)((float*)(p.ws + WS_XC) + (size_t)(r - T_LAT) * DM + 4 * lane + 256 * j) = v[j]; }
            }
            NORM_EMIT(v, r);
        }
    }
#undef NORM_PARAMS
#undef NORM_EMIT
}

DI void ph_rw_prep(const Params& p, int l, unsigned char* lds, int bid, int G, int tid) {
    typedef short bf16x8 __attribute__((ext_vector_type(8)));
    bf16_t* X = (bf16_t*)lds;
    const bf16_t* PX = (const bf16_t*)(p.ws + WS_PX);
    const int lane = tid & 63, w = __builtin_amdgcn_readfirstlane(tid >> 6), li = lane & 15, q = lane >> 4;
    for (int it = bid; it < 2 * 272; it += G) {
        const int d = it / 272, row0 = (it % 272) * 64;
        const float* mu = p.in[18] + (size_t)(l * 2 + d) * 1792 + 1536;
        __syncthreads();
#pragma unroll 8
        for (int i = 0; i < 16; ++i) { const int idx = tid + 512 * i; const int tok = idx >> 7, cp = idx & 127, col = 2 * cp; const int row = row0 + tok;
            const int t = row < T_LAT ? (row & 4095) : ((row - T_LAT) & 255); const int L = row < T_LAT ? 4096 : 256;
            const bool valid = d ? (t < L - 1) : (t > 0); const int pr = d ? row + 1 : row - 1;
            const unsigned uv = *(const unsigned*)(PX + (size_t)row * NINP + RWO + 1536 + col); const unsigned up = valid ? *(const unsigned*)(PX + (size_t)pr * NINP + RWO + 1536 + col) : 0u;
            const float v0 = bflo(uv), v1 = bfhi(uv); const float m0 = v0 + (bflo(up) - v0) * mu[col], m1 = v1 + (bfhi(up) - v1) * mu[col + 1];
            const float o0 = col < 64 ? tanh_fast(m0) : (col < 128 ? m0 : sigm(m0)), o1 = col < 64 ? tanh_fast(m1) : (col < 128 ? m1 : sigm(m1));
            *(unsigned*)(X + tok * 264 + col) = pk2(o0, o1); }
        __syncthreads();
        const bf16_t* WT = (const bf16_t*)(p.ws + WS_LW) + (size_t)d * 131072;
#pragma unroll 1
        for (int part = 0; part < 3; ++part) {
            const int K = part == 2 ? 128 : 64, koff = part == 0 ? 0 : (part == 1 ? 64 : 128), nks = K / 32;
            const bf16_t* Wp = WT + (part == 0 ? 0 : (part == 1 ? 32768 : 65536));
            bf16_t* OUT = (bf16_t*)(p.ws + WS_H + (size_t)((part == 0 ? 0 : (part == 1 ? 2 : 4)) + d) * MSU);
            bf16x8 Af[4][4];
#pragma unroll
            for (int ct = 0; ct < 4; ++ct)
#pragma unroll
                for (int ks = 0; ks < 4; ++ks) if (ks < nks) Af[ct][ks] = *(const bf16x8*)(Wp + (size_t)(64 * w + 16 * ct + li) * K + 32 * ks + 8 * q);
            f32x4 bias[4];
#pragma unroll
            for (int ct = 0; ct < 4; ++ct) { const int ch = 64 * w + 16 * ct + 4 * q;
                bias[ct] = part == 0 ? *(const f32x4*)(p.in[19] + (l * 2 + d) * 512 + ch) : (part == 1 ? *(const f32x4*)(p.in[21] + (l * 2 + d) * 512 + ch) : (f32x4){0.f, 0.f, 0.f, 0.f}); }
#pragma unroll 1
            for (int tt = 0; tt < 4; ++tt) {
                bf16x8 Bf[4];
#pragma unroll
                for (int ks = 0; ks < 4; ++ks) if (ks < nks) Bf[ks] = *(const bf16x8*)(X + (16 * tt + li) * 264 + koff + 32 * ks + 8 * q);
#pragma unroll
                for (int ct = 0; ct < 4; ++ct) { f32x4 acc = (f32x4){0.f, 0.f, 0.f, 0.f};
#pragma unroll
                    for (int ks = 0; ks < 4; ++ks) if (ks < nks) acc = __builtin_amdgcn_mfma_f32_16x16x32_bf16(Af[ct][ks], Bf[ks], acc, 0, 0, 0);
                    acc += bias[ct];
                    if (part == 0) { for (int e = 0; e < 4; ++e) acc[e] = 0.6065306597126334f * sigm(acc[e]); }
                    else if (part == 1) { for (int e = 0; e < 4; ++e) acc[e] = sigm(acc[e]); }
                    u32x2 o; o.x = pk2(acc[0], acc[1]); o.y = pk2(acc[2], acc[3]);
                    *(u32x2*)(OUT + (size_t)(row0 + 16 * tt + li) * 512 + 64 * w + 16 * ct + 4 * q) = o; }
            }
        }
    }
    __syncthreads();
}

DI void ph_gd_prep(const Params& p, int l, unsigned char* lds, int bid, int G, int tid, int lane, int wave) {
    unsigned* buf = (unsigned*)lds;
    bf16_t* PX = (bf16_t*)(p.ws + WS_PX);
    const float* cw = p.in[29] + (size_t)l * 4 * 1536;
    for (int it = (bid + 192) % G; it < 3072 + 48; it += G) {
        int row0, NT, sl;
        if (it >= 48) { const int il = it - 48; const int b = il / 768, rem = il % 768; row0 = b * 4096 + (rem / 12) * 64; sl = rem % 12; NT = 64; }
        else { row0 = T_LAT + (it / 12) * 256; sl = it % 12; NT = 256; }
        const int col0 = GDO + sl * 128;
        __syncthreads();
#pragma unroll 8
        for (int idx = tid; idx < NT * 64; idx += 512) { const int tt = idx >> 6, c2 = idx & 63; buf[idx] = *(const unsigned*)(PX + (size_t)(row0 + tt) * NINP + col0 + 2 * c2); }
        __syncthreads();
        const int c = sl * 128 + 2 * lane;
        float w0[4], w1[4];
#pragma unroll
        for (int j = 0; j < 4; ++j) { w0[j] = cw[j * 1536 + c]; w1[j] = cw[j * 1536 + c + 1]; }
        for (int tt = wave; tt < NT; tt += 8) { float y0 = 0.f, y1 = 0.f;
#pragma unroll
            for (int j = 0; j < 4; ++j) { const int ts = tt - 2 + j; if (ts >= 0 && ts < NT) { const unsigned u = buf[ts * 64 + lane]; y0 += bflo(u) * w0[j]; y1 += bfhi(u) * w1[j]; } }
            y0 = siluf(y0); y1 = siluf(y1);
            if (sl < 8) { const float ss = wave_sum_fast(y0 * y0 + y1 * y1); const float sc = rsqrtf(ss + 1e-6f) * (sl < 4 ? 0.08838834764831845f : 1.f); y0 *= sc; y1 *= sc; }
            *(unsigned*)(PX + (size_t)(row0 + tt) * NINP + col0 + 2 * lane) = pk2(y0, y1); }
    }
    __syncthreads();
}

DI void ph_rg_prep(const Params& p, int l, unsigned char* lds, int bid, int G, int tid) {
    typedef short bf16x8 __attribute__((ext_vector_type(8)));
    bf16_t* X = (bf16_t*)lds;
    const bf16_t* PX = (const bf16_t*)(p.ws + WS_PX);
    const int lane = tid & 63, w = __builtin_amdgcn_readfirstlane(tid >> 6), li = lane & 15, q = lane >> 4;
    const int c = tid;
    float cw[4];
#pragma unroll
    for (int j = 0; j < 4; ++j) cw[j] = p.in[33][(size_t)l * 4 * 512 + j * 512 + c];
    const float cb = p.in[34][l * 512 + c];
    for (int it = (bid + 224) % G; it < 544; it += G) {
        const int row0 = it * 32; const bool lat = row0 < T_LAT; const int t0 = lat ? (row0 & 63) : ((row0 - T_LAT) & 255); const int tend = lat ? 64 : 256;
        __syncthreads();
        { bf16_t pxv[35];
          const bf16_t* px = PX + (size_t)row0 * NINP + RGO + c;
#pragma unroll
          for (int k = 0; k < 35; ++k) { const int tt = t0 + k - 2; pxv[k] = (tt >= 0 && tt < tend) ? px[(ptrdiff_t)(k - 2) * NINP] : (bf16_t)0; }
#pragma unroll
          for (int k = 0; k < 32; ++k) X[k * 520 + c] = f2bf(cb + bf2f(pxv[k]) * cw[0] + bf2f(pxv[k + 1]) * cw[1] + bf2f(pxv[k + 2]) * cw[2] + bf2f(pxv[k + 3]) * cw[3]); }
        __syncthreads();
        const int n = w >> 1, jh = w & 1;
#pragma unroll 1
        for (int d = 0; d < 2; ++d) {
            bf16_t* LA = (bf16_t*)(p.ws + WS_H + (size_t)(10 + d) * MSU); bf16_t* BB = (bf16_t*)(p.ws + WS_H + (size_t)(12 + d) * MSU);
            const bf16_t* WA = (const bf16_t*)(p.ws + WS_RGW) + (size_t)(d * 8 + n) * 16384; const bf16_t* WX = WA + (size_t)4 * 16384;
#pragma unroll 1
            for (int jt = 0; jt < 4; ++jt) {
                const int j = 64 * jh + 16 * jt + li; bf16x8 Ar[4], Ai[4];
#pragma unroll
                for (int ks = 0; ks < 4; ++ks) { Ar[ks] = *(const bf16x8*)(WA + (size_t)j * 128 + 32 * ks + 8 * q); Ai[ks] = *(const bf16x8*)(WX + (size_t)j * 128 + 32 * ks + 8 * q); }
                const int c4 = n * 128 + 64 * jh + 16 * jt + 4 * q;
                const f32x4 ba = *(const f32x4*)(p.in[36] + (l * 2 + d) * 512 + c4), bx = *(const f32x4*)(p.in[38] + (l * 2 + d) * 512 + c4), lam = *(const f32x4*)(p.in[39] + (l * 2 + d) * 512 + c4);
                f32x4 sp;
#pragma unroll
                for (int e = 0; e < 4; ++e) sp[e] = softplusf(-lam[e]);
#pragma unroll 1
                for (int tt = 0; tt < 2; ++tt) { f32x4 ar = (f32x4){0.f, 0.f, 0.f, 0.f}, ai = (f32x4){0.f, 0.f, 0.f, 0.f};
#pragma unroll
                    for (int ks = 0; ks < 4; ++ks) { const bf16x8 Bf = *(const bf16x8*)(X + (16 * tt + li) * 520 + n * 128 + 32 * ks + 8 * q);
                        ar = __builtin_amdgcn_mfma_f32_16x16x32_bf16(Ar[ks], Bf, ar, 0, 0, 0); ai = __builtin_amdgcn_mfma_f32_16x16x32_bf16(Ai[ks], Bf, ai, 0, 0, 0); }
                    const u32x2 xx = *(const u32x2*)(X + (16 * tt + li) * 520 + c4); const float xc[4] = {bflo(xx.x), bfhi(xx.x), bflo(xx.y), bfhi(xx.y)};
                    float la[4], bb[4];
#pragma unroll
                    for (int e = 0; e < 4; ++e) { const float gr = sigm(ar[e] + ba[e]), gi = sigm(ai[e] + bx[e]); la[e] = -8.f * gr * sp[e]; bb[e] = __builtin_amdgcn_sqrtf(fmaxf(1.f - __expf(2.f * la[e]), 0.f)) * (gi * xc[e]); }
                    u32x2 o1, o2; o1.x = pk2(la[0], la[1]); o1.y = pk2(la[2], la[3]); o2.x = pk2(bb[0], bb[1]); o2.y = pk2(bb[2], bb[3]);
                    const size_t oo = (size_t)(row0 + 16 * tt + li) * 512 + c4; *(u32x2*)(LA + oo) = o1; *(u32x2*)(BB + oo) = o2; }
            }
        }
    }
    __syncthreads();
}

DI void ph_hy_prep(const Params& p, int l, unsigned char* lds, int bid, int G, int tid) {
    const bf16_t* PX = (const bf16_t*)(p.ws + WS_PX);
    bf16_t* ZL = (bf16_t*)lds; bf16_t* XL = ZL + 512 * 64;
    __syncthreads();
    bf16_t* ZT = (bf16_t*)(p.ws + WS_H + (size_t)14 * MSU); bf16_t* X0T = (bf16_t*)(p.ws + WS_H + (size_t)15 * MSU);
    const float* cw = p.in[10] + (size_t)l * 3 * 1536; const int c = tid;
    float wv[3], w0[3], w1[3];
#pragma unroll
    for (int j = 0; j < 3; ++j) { wv[j] = cw[j * 1536 + c]; w0[j] = cw[j * 1536 + 512 + c]; w1[j] = cw[j * 1536 + 1024 + c]; }
    const int nit = (l == 0) ? 256 + 16 : 256;
    for (int it = (bid + 128) % G; it < nit; it += G) {
        int row0, L, t0, b; size_t zoff;
        if (it < 256) { b = it >> 6; t0 = (it & 63) * 64; L = 4096; row0 = b * 4096 + t0; zoff = ((size_t)b * 512 + c) * 4096 + t0; }
        else { const int ic = it - 256; b = ic >> 2; t0 = (ic & 3) * 64; L = 256; row0 = T_LAT + b * 256 + t0; zoff = (size_t)4 * 512 * 4096 + ((size_t)b * 512 + c) * 256 + t0; }
        const int rowlen = (it < 256) ? 64 : 256;
        const int tlo = (t0 / rowlen) * rowlen, thi = tlo + rowlen;
        float pv[3], p0[3], p1[3];
        { const bool ok = (t0 - 1) >= tlo; const bf16_t* q = PX + (size_t)(row0 - 1) * NINP + HYO + c;
          pv[0] = ok ? bf2f(q[0]) : 0.f; p0[0] = ok ? bf2f(q[512]) : 0.f; p1[0] = ok ? bf2f(q[1024]) : 0.f; }
        { const bf16_t* q = PX + (size_t)row0 * NINP + HYO + c; pv[1] = bf2f(q[0]); p0[1] = bf2f(q[512]); p1[1] = bf2f(q[1024]); }
#pragma unroll 1
        for (int k8 = 0; k8 < 8; ++k8) { unsigned zz[4], xx[4];
#pragma unroll
            for (int k = 0; k < 8; ++k) { const int tt = k8 * 8 + k; const bool ok = (t0 + tt + 1) < thi; const bf16_t* q = PX + (size_t)(row0 + tt + 1) * NINP + HYO + c;
                pv[2] = ok ? bf2f(q[0]) : 0.f; p0[2] = ok ? bf2f(q[512]) : 0.f; p1[2] = ok ? bf2f(q[1024]) : 0.f;
                const float v = pv[0] * wv[0] + pv[1] * wv[1] + pv[2] * wv[2], x0 = p0[0] * w0[0] + p0[1] * w0[1] + p0[2] * w0[2], x1 = p1[0] * w1[0] + p1[1] * w1[1] + p1[2] * w1[2];
                const unsigned zb = f2bf(x1 * v), xb = f2bf(x0);
                if (k & 1) { zz[k >> 1] |= zb << 16; xx[k >> 1] |= xb << 16; } else { zz[k >> 1] = zb; xx[k >> 1] = xb; }
                pv[0] = pv[1]; pv[1] = pv[2]; p0[0] = p0[1]; p0[1] = p0[2]; p1[0] = p1[1]; p1[1] = p1[2]; }
            u32x4 zo, xo; zo.x = zz[0]; zo.y = zz[1]; zo.z = zz[2]; zo.w = zz[3]; xo.x = xx[0]; xo.y = xx[1]; xo.z = xx[2]; xo.w = xx[3];
            *(u32x4*)(ZL + c * 64 + k8 * 8) = zo; *(u32x4*)(XL + c * 64 + k8 * 8) = xo; }
        (void)L;
        __syncthreads();
        {
            const int lane = tid & 63, w = tid >> 6, cs = lane >> 3, ck = lane & 7;
#pragma unroll
            for (int i = 0; i < 8; ++i) { const int ch = 64 * w + 8 * i + cs; const size_t zo2 = zoff + ((size_t)ch - c) * (size_t)(it < 256 ? 4096 : 256) + 8 * ck;
                *(u32x4*)(ZT + zo2) = *(const u32x4*)(ZL + ch * 64 + 8 * ck); *(u32x4*)(X0T + zo2) = *(const u32x4*)(XL + ch * 64 + 8 * ck); }
        }
        __syncthreads();
    }
}

typedef float f32x2v __attribute__((ext_vector_type(2)));

DI void rw_scan(const Params& p, int l, int item, unsigned char* lds, int tid, int lane, int wave) {
    const int d = item >> 6, b = (item >> 4) & 3, h = (item >> 1) & 7, rh = item & 1;
    float* SB = (float*)lds;
    float* YB = (float*)(lds + 2 * 32 * 392 * 4);
    const bf16_t* PX = (const bf16_t*)(p.ws + WS_PX);
    const bf16_t* E = (const bf16_t*)(p.ws + WS_H + (size_t)(0 + d) * MSU); const bf16_t* AA = (const bf16_t*)(p.ws + WS_H + (size_t)(2 + d) * MSU);
    bf16_t* Y = (bf16_t*)(p.ws + WS_H + (size_t)(6 + d) * MSU);
    __syncthreads();
    if (wave >= 4) {
        const int hw = wave - 4, ch = h * 64 + lane;
        const float* mu = p.in[18] + (size_t)(l * 2 + d) * 1792;
        const float mur = mu[ch], muk = mu[512 + ch], muv = mu[1024 + ch];
        const float kkw = p.in[24][(l * 2 + d) * 512 + ch], kaw = p.in[25][(l * 2 + d) * 512 + ch];
        bf16_t gr[8], gk[8], gv[8], gpr[8], gpk[8], gpv[8], ge[8], ga[8];
        bf16_t nr[8], nk[8], nv[8], npr[8], npk[8], npv[8], ne[8], na[8];
#define RW_GLOAD(blkx, R, K_, V_, PR, PK, PV, E_, A_) do { _Pragma("unroll") for (int j = 0; j < 8; ++j) { bool first; const int row = scan_row((blkx) * 32 + hw * 8 + j, d, b, first); \
            const bf16_t* q = PX + (size_t)row * NINP + RWO + ch; R[j] = q[0]; K_[j] = q[512]; V_[j] = q[1024]; \
            const bf16_t* qp = PX + (size_t)(first ? row : (d ? row + 1 : row - 1)) * NINP + RWO + ch; \
            PR[j] = first ? (bf16_t)0 : qp[0]; PK[j] = first ? (bf16_t)0 : qp[512]; PV[j] = first ? (bf16_t)0 : qp[1024]; \
            E_[j] = E[(size_t)row * 512 + ch]; A_[j] = AA[(size_t)row * 512 + ch]; } } while (0)
        RW_GLOAD(0, gr, gk, gv, gpr, gpk, gpv, ge, ga);
#pragma unroll 1
        for (int blk = -1; blk < 136; ++blk) {
            if (blk + 2 < 136) RW_GLOAD(blk + 2, nr, nk, nv, npr, npk, npv, ne, na);
            if (blk >= 1) {
                const int hid = hw * 64 + lane, s = hid >> 3, c4 = (hid & 7) * 4; bool first; const int row = scan_row((blk - 1) * 32 + s, d, b, first);
                const f32x4 y0 = *(const f32x4*)(YB + ((blk - 1) & 1) * 1024 + s * 32 + c4);
                u32x2 w2; w2.x = pk2(y0[0], y0[1]); w2.y = pk2(y0[2], y0[3]);
                *(u32x2*)(Y + (size_t)row * 512 + h * 64 + rh * 32 + c4) = w2; }
            if (blk + 1 < 136) {
                float* sbn = SB + ((blk + 1) & 1) * 32 * 392;
#pragma unroll
                for (int j = 0; j < 8; ++j) { float* st = sbn + (hw * 8 + j) * 392;
                    const float pr = bf2f(gr[j]), pk = bf2f(gk[j]), pv = bf2f(gv[j]);
                    const float r = pr + (bf2f(gpr[j]) - pr) * mur, k = pk + (bf2f(gpk[j]) - pk) * muk, v = pv + (bf2f(gpv[j]) - pv) * muv;
                    const float a = bf2f(ga[j]), w = __expf(-bf2f(ge[j])); const float kkr = k * kkw; const float n2 = wave_sum_fast(kkr * kkr);
                    const float kk = kkr * __builtin_amdgcn_rsqf(fmaxf(n2, 1e-24f)); const float kka = kk * a, kp = k * (1.f + (a - 1.f) * kaw);
                    const float c1 = wave_sum_fast(kka * r), c2 = wave_sum_fast(kp * r);
                    st[lane] = w; st[64 + lane] = kk; st[128 + lane] = kka; st[192 + lane] = kp; st[256 + lane] = w * r; st[320 + lane] = v; if (lane == 0) { st[384] = c1; st[385] = c2; } }
            }
#pragma unroll
            for (int j = 0; j < 8; ++j) { gr[j] = nr[j]; gk[j] = nk[j]; gv[j] = nv[j]; gpr[j] = npr[j]; gpk[j] = npk[j]; gpv[j] = npv[j]; ge[j] = ne[j]; ga[j] = na[j]; }
            LDS_BARRIER();
        }
#undef RW_GLOAD
        {
            const int hid = hw * 64 + lane, s = hid >> 3, c4 = (hid & 7) * 4; bool first; const int row = scan_row(135 * 32 + s, d, b, first);
            const f32x4 y0 = *(const f32x4*)(YB + (135 & 1) * 1024 + s * 32 + c4);
            u32x2 w2; w2.x = pk2(y0[0], y0[1]); w2.y = pk2(y0[2], y0[3]);
            *(u32x2*)(Y + (size_t)row * 512 + h * 64 + rh * 32 + c4) = w2; }
    } else {
        const int rloc = wave * 8 + (lane >> 3), rowv = rh * 32 + rloc, kq = lane & 7;
        f32x2v S[4];
#pragma unroll
        for (int i = 0; i < 4; ++i) S[i] = (f32x2v){0.f, 0.f};
        __builtin_amdgcn_s_setprio(3);
        LDS_BARRIER();
        struct Ops { f32x4 kkv[2], wrv[2], wv[2], kav[2], kpv[2]; float vv, c1, c2; };
#define RW_OPS(o, stp) do { const float* st_ = (stp); _Pragma("unroll") for (int r = 0; r < 2; ++r) { (o).kkv[r] = *(const f32x4*)(st_ + 64 + 4 * r); (o).wrv[r] = *(const f32x4*)(st_ + 256 + 4 * r); \
            (o).wv[r] = *(const f32x4*)(st_ + 4 * r); (o).kav[r] = *(const f32x4*)(st_ + 128 + 4 * r); (o).kpv[r] = *(const f32x4*)(st_ + 192 + 4 * r); } \
            (o).vv = st_[320 - 8 * kq + rowv]; (o).c1 = st_[384 - 8 * kq]; (o).c2 = st_[385 - 8 * kq]; } while (0)
#pragma unroll 1
        for (int blk = 0; blk < 136; ++blk) {
            const float* sb = SB + (blk & 1) * 32 * 392 + 8 * kq; float* yb = YB + (blk & 1) * 1024 + rloc;
            Ops cur; RW_OPS(cur, sb);
#pragma unroll
            for (int s = 0; s < 32; ++s) {
                Ops nxt; RW_OPS(nxt, sb + (s < 31 ? s + 1 : s) * 392);
                f32x2v sa = (f32x2v){0.f, 0.f}, sb2 = (f32x2v){0.f, 0.f}, ya = (f32x2v){0.f, 0.f}, yb2 = (f32x2v){0.f, 0.f};
#pragma unroll
                for (int r = 0; r < 2; ++r) { sa += S[2 * r] * (f32x2v){cur.kkv[r][0], cur.kkv[r][1]}; sb2 += S[2 * r + 1] * (f32x2v){cur.kkv[r][2], cur.kkv[r][3]};
                                              ya += S[2 * r] * (f32x2v){cur.wrv[r][0], cur.wrv[r][1]}; yb2 += S[2 * r + 1] * (f32x2v){cur.wrv[r][2], cur.wrv[r][3]}; }
                sa += sb2; ya += yb2;
                float sk = sa.x + sa.y, yy = ya.x + ya.y;
                sk += DPPF(sk, 0xB1); yy += DPPF(yy, 0xB1); sk += DPPF(sk, 0x4E); yy += DPPF(yy, 0x4E); sk += DPPF(sk, 0x141); yy += DPPF(yy, 0x141);
                const f32x2v vv2 = (f32x2v){cur.vv, cur.vv}, sk2 = (f32x2v){sk, sk};
#pragma unroll
                for (int r = 0; r < 2; ++r) {
                    S[2 * r] = S[2 * r] * (f32x2v){cur.wv[r][0], cur.wv[r][1]} + (vv2 * (f32x2v){cur.kpv[r][0], cur.kpv[r][1]} - sk2 * (f32x2v){cur.kav[r][0], cur.kav[r][1]});
                    S[2 * r + 1] = S[2 * r + 1] * (f32x2v){cur.wv[r][2], cur.wv[r][3]} + (vv2 * (f32x2v){cur.kpv[r][2], cur.kpv[r][3]} - sk2 * (f32x2v){cur.kav[r][2], cur.kav[r][3]}); }
                if (kq == 0) yb[s * 32] = yy - sk * cur.c1 + cur.vv * cur.c2;
                cur = nxt;
            }
            LDS_BARRIER();
        }
#undef RW_OPS
        __builtin_amdgcn_s_setprio(0);
    }
    __syncthreads();
}

DI void gd_scan(const Params& p, int l, int item, unsigned char* lds, int tid, int lane, int wave) {
    const int d = item >> 6, b = (item >> 4) & 3, h = (item >> 2) & 3, vq = item & 3;
    float* SB = (float*)lds;
    float* YB = (float*)(lds + 2 * 32 * 360 * 4);
    const bf16_t* PX = (const bf16_t*)(p.ws + WS_PX);
    bf16_t* O = (bf16_t*)(p.ws + WS_H + (size_t)(8 + d) * MSU);
    __syncthreads();
    if (wave >= 4) {
        const int hw = wave - 4;
        const float nA = -__expf(p.in[30][(l * 2 + d) * 4 + h]), dtb = p.in[31][(l * 2 + d) * 4 + h];
        const int kidx = ((2 * lane) >> 4) * 20 + ((2 * lane) & 15);
        unsigned gq[8], gk[8]; bf16_t gv[8], gg[8], gb[8]; unsigned nq[8], nk[8]; bf16_t nv[8], ng[8], nb[8];
#define GD_GLOAD(blkx, Q_, K_, V_, G_, B_) do { _Pragma("unroll") for (int j = 0; j < 8; ++j) { bool first; const int row = scan_row((blkx) * 32 + hw * 8 + j, d, b, first); \
            const bf16_t* q = PX + (size_t)row * NINP + GDO; Q_[j] = *(const unsigned*)(q + h * 128 + 2 * lane); K_[j] = *(const unsigned*)(q + 512 + h * 128 + 2 * lane); \
            V_[j] = q[1024 + h * 128 + vq * 32 + (lane & 31)]; G_[j] = q[2048 + d * 4 + h]; B_[j] = q[2048 + (2 + d) * 4 + h]; } } while (0)
        GD_GLOAD(0, gq, gk, gv, gg, gb);
#pragma unroll 1
        for (int blk = -1; blk < 136; ++blk) {
            if (blk + 2 < 136) GD_GLOAD(blk + 2, nq, nk, nv, ng, nb);
            if (blk >= 1) { const int hid = hw * 64 + lane, s = hid >> 3, c4 = (hid & 7) * 4; bool first; const int row = scan_row((blk - 1) * 32 + s, d, b, first);
                const f32x4 y0 = *(const f32x4*)(YB + ((blk - 1) & 1) * 1024 + s * 32 + c4);
                u32x2 w2; w2.x = pk2(y0[0], y0[1]); w2.y = pk2(y0[2], y0[3]); *(u32x2*)(O + (size_t)row * 512 + h * 128 + vq * 32 + c4) = w2; }
            if (blk + 1 < 136) {
                float* sbn = SB + ((blk + 1) & 1) * 32 * 360;
#pragma unroll
                for (int j = 0; j < 8; ++j) { float* st = sbn + (hw * 8 + j) * 360;
                    const float q0 = bflo(gq[j]), q1 = bfhi(gq[j]), k0 = bflo(gk[j]), k1 = bfhi(gk[j]); const float qk = wave_sum_fast(q0 * k0 + q1 * k1);
                    st[kidx] = k0; st[kidx + 1] = k1; st[160 + kidx] = q0; st[161 + kidx] = q1; if (lane < 32) st[320 + lane] = bf2f(gv[j]);
                    if (lane == 0) { const float xg = bf2f(gg[j]) + dtb; const float spl = fmaxf(xg, 0.f) + __logf(1.f + __expf(-fabsf(xg)));
                        st[352] = __expf(nA * spl); st[353] = sigm(bf2f(gb[j])); st[354] = qk; } }
            }
#pragma unroll
            for (int j = 0; j < 8; ++j) { gq[j] = nq[j]; gk[j] = nk[j]; gv[j] = nv[j]; gg[j] = ng[j]; gb[j] = nb[j]; }
            LDS_BARRIER();
        }
#undef GD_GLOAD
        { const int hid = hw * 64 + lane, s = hid >> 3, c4 = (hid & 7) * 4; bool first; const int row = scan_row(135 * 32 + s, d, b, first);
          const f32x4 y0 = *(const f32x4*)(YB + (135 & 1) * 1024 + s * 32 + c4);
          u32x2 w2; w2.x = pk2(y0[0], y0[1]); w2.y = pk2(y0[2], y0[3]); *(u32x2*)(O + (size_t)row * 512 + h * 128 + vq * 32 + c4) = w2; }
    } else {
        const int vloc = wave * 8 + (lane >> 3), kq = lane & 7;
        f32x2v S[8];
#pragma unroll
        for (int i = 0; i < 8; ++i) S[i] = (f32x2v){0.f, 0.f};
        __builtin_amdgcn_s_setprio(3);
        LDS_BARRIER();
        struct Ops { f32x4 kv[4], qv[4]; float vv, alpha, beta, qk; };
#define GD_OPS(o, stp) do { const float* st_ = (stp); _Pragma("unroll") for (int r = 0; r < 4; ++r) { (o).kv[r] = *(const f32x4*)(st_ + kq * 20 + 4 * r); (o).qv[r] = *(const f32x4*)(st_ + 160 + kq * 20 + 4 * r); } \
            (o).vv = st_[320 + vloc]; (o).alpha = st_[352]; (o).beta = st_[353]; (o).qk = st_[354]; } while (0)
#pragma unroll 1
        for (int blk = 0; blk < 136; ++blk) {
            const float* sb = SB + (blk & 1) * 32 * 360; float* yb = YB + (blk & 1) * 1024 + vloc;
            Ops cur; GD_OPS(cur, sb);
#pragma unroll
            for (int s = 0; s < 32; ++s) {
                Ops nxt; GD_OPS(nxt, sb + (s < 31 ? s + 1 : s) * 360);
                f32x2v ka = (f32x2v){0.f, 0.f}, kb = (f32x2v){0.f, 0.f}, qa = (f32x2v){0.f, 0.f}, qb = (f32x2v){0.f, 0.f};
#pragma unroll
                for (int r = 0; r < 4; ++r) { ka += S[2 * r] * (f32x2v){cur.kv[r][0], cur.kv[r][1]}; kb += S[2 * r + 1] * (f32x2v){cur.kv[r][2], cur.kv[r][3]};
                                              qa += S[2 * r] * (f32x2v){cur.qv[r][0], cur.qv[r][1]}; qb += S[2 * r + 1] * (f32x2v){cur.qv[r][2], cur.qv[r][3]}; }
                ka += kb; qa += qb;
                float kS = ka.x + ka.y, qS = qa.x + qa.y;
                kS += DPPF(kS, 0xB1); qS += DPPF(qS, 0xB1); kS += DPPF(kS, 0x4E); qS += DPPF(qS, 0x4E); kS += DPPF(kS, 0x141); qS += DPPF(qS, 0x141);
                const float vnew = cur.beta * (cur.vv - cur.alpha * kS);
                const f32x2v al2 = (f32x2v){cur.alpha, cur.alpha}, vn2 = (f32x2v){vnew, vnew};
#pragma unroll
                for (int r = 0; r < 4; ++r) { S[2 * r] = al2 * S[2 * r] + (f32x2v){cur.kv[r][0], cur.kv[r][1]} * vn2; S[2 * r + 1] = al2 * S[2 * r + 1] + (f32x2v){cur.kv[r][2], cur.kv[r][3]} * vn2; }
                if (kq == 0) yb[s * 32] = cur.alpha * qS + cur.qk * vnew;
                cur = nxt;
            }
            LDS_BARRIER();
        }
#undef GD_OPS
        __builtin_amdgcn_s_setprio(0);
    }
    __syncthreads();
}

DI void rg_scan(const Params& p, int item, unsigned char* lds, int lane, int wave) {
    const int d = item >> 5, b = (item >> 3) & 3, c = (item & 7) * 64 + lane;
    bf16_t* LA = (bf16_t*)(p.ws + WS_H + (size_t)(10 + d) * MSU); const bf16_t* BB = (const bf16_t*)(p.ws + WS_H + (size_t)(12 + d) * MSU);
    float* XP = (float*)lds;
    float* XH = XP + 512;
    const int st = d ? -1 : 1;
    float carry = 0.f;
    __syncthreads();
#pragma unroll 1
    for (int pass = 0; pass < 2; ++pass) {
        float h = carry, prod = 1.f;
        bf16_t cl[16], cb[16], nl[16], nb[16];
        { bool first; const int row0 = scan_row((wave * 34) * 16, d, b, first);
#pragma unroll
          for (int s = 0; s < 16; ++s) { const size_t o = (size_t)(row0 + st * s) * 512 + c; cl[s] = LA[o]; cb[s] = BB[o]; } }
#pragma unroll 2
        for (int bi = 0; bi < 34; ++bi) { const int blk = wave * 34 + bi; bool first;
            if (bi + 1 < 34) { const int rown = scan_row((blk + 1) * 16, d, b, first);
#pragma unroll
                for (int s = 0; s < 16; ++s) { const size_t o = (size_t)(rown + st * s) * 512 + c; nl[s] = LA[o]; nb[s] = BB[o]; } }
            const int row0 = scan_row(blk * 16, d, b, first);
#pragma unroll
            for (int s = 0; s < 16; ++s) { const float a = __expf(bf2f(cl[s])); h = a * h + bf2f(cb[s]); prod *= a; cl[s] = f2bf(h); }
            if (pass == 1) {
#pragma unroll
                for (int s = 0; s < 16; ++s) LA[(size_t)(row0 + st * s) * 512 + c] = cl[s]; }
#pragma unroll
            for (int s = 0; s < 16; ++s) { cl[s] = nl[s]; cb[s] = nb[s]; }
        }
        if (pass == 0) { XP[wave * 64 + lane] = prod; XH[wave * 64 + lane] = h;
            __syncthreads();
            float cr = 0.f;
            for (int w = 0; w < wave; ++w) cr = XP[w * 64 + lane] * cr + XH[w * 64 + lane];
            carry = cr; }
    }
    __syncthreads();
}

struct __attribute__((packed, aligned(4))) V16A4 { unsigned a, b, c, d; };
DI void hy_conv_mfma(const Params& p, int l, int c, unsigned char* lds, int tid) {
    typedef short bf16x8 __attribute__((ext_vector_type(8)));
    bf16_t* G0 = (bf16_t*)lds;
    bf16_t* G1 = G0 + 8208;
    bf16_t* Zs = G1 + 8208;
    bf16_t* ZT = (bf16_t*)(p.ws + WS_H + (size_t)14 * MSU); const bf16_t* X0T = (const bf16_t*)(p.ws + WS_H + (size_t)15 * MSU);
    const float* HG = (const float*)(p.ws + WS_HGL);
    const float inorm = ((const float*)(p.ws + WS_INORM))[c]; const float skip = p.in[17][l * 512 + c];
    __syncthreads();
    for (int idx = tid; idx < 8208; idx += 512) { const int x = idx - 4104; float v = 0.f;
        if (x >= -4095 && x <= 4095) v = x <= 0 ? HG[(size_t)c * 4096 - x] : HG[(size_t)(512 + c) * 4096 + x];
        const bf16_t bv = f2bf(v); G0[idx] = bv; if (idx + 1 < 8208) G1[idx + 1] = bv; if (idx == 0) G1[0] = 0; }
    for (int idx = tid; idx < 2048; idx += 512) { const int b = idx >> 9, rem = idx & 511, a = rem >> 3, j8 = rem & 7;
        *(u32x4*)(Zs + (b * 64 + a) * 72 + 8 * j8) = *(const u32x4*)(ZT + ((size_t)b * 512 + c) * 4096 + 64 * a + 8 * j8); }
    __syncthreads();
    const int lane = tid & 63, w = __builtin_amdgcn_readfirstlane(tid >> 6), i = lane & 15, q = lane >> 4;
    const int b = w >> 1, a0 = (w & 1) * 32;
    const bf16_t* gl = ((i & 1) ? G1 + 1 : G0) + 4104 + 8 * q - i;
    f32x4 acc[4][2];
#pragma unroll
    for (int m = 0; m < 4; ++m) { acc[m][0] = (f32x4){0.f, 0.f, 0.f, 0.f}; acc[m][1] = (f32x4){0.f, 0.f, 0.f, 0.f}; }
    bf16x8 F[6];
#pragma unroll
    for (int o = 0; o < 6; ++o) F[o] = (bf16x8){0, 0, 0, 0, 0, 0, 0, 0};
    const int dlo = a0 - 63, dhi = a0 + 31;
#pragma unroll 2
    for (int dl = dlo; dl <= dhi; ++dl) {
        const bf16_t* gd = gl - 64 * dl;
        if (dl == dlo) { F[4] = __builtin_bit_cast(bf16x8, *(const V16A4*)(gd + 16)); F[5] = __builtin_bit_cast(bf16x8, *(const V16A4*)(gd + 32)); }
        else { F[4] = F[0]; F[5] = F[1]; }
#pragma unroll
        for (int o = 0; o < 4; ++o) F[o] = __builtin_bit_cast(bf16x8, *(const V16A4*)(gd - 48 + 16 * o));
        bf16x8 Bf[2][2];
#pragma unroll
        for (int n = 0; n < 2; ++n) { const int ap = a0 + 16 * n + i - dl; const bool ok = (unsigned)ap < 64u; const int apc = ok ? ap : 0;
#pragma unroll
            for (int kk = 0; kk < 2; ++kk) { const bf16x8 v = *(const bf16x8*)(Zs + (b * 64 + apc) * 72 + 32 * kk + 8 * q); Bf[n][kk] = ok ? v : (bf16x8){0, 0, 0, 0, 0, 0, 0, 0}; } }
#pragma unroll
        for (int m = 0; m < 4; ++m)
#pragma unroll
            for (int n = 0; n < 2; ++n)
#pragma unroll
                for (int kk = 0; kk < 2; ++kk) acc[m][n] = __builtin_amdgcn_mfma_f32_16x16x32_bf16(F[2 * kk - m + 3], Bf[n][kk], acc[m][n], 0, 0, 0);
    }
#pragma unroll
    for (int m = 0; m < 4; ++m)
#pragma unroll
        for (int n = 0; n < 2; ++n) { const int a = a0 + 16 * n + i, i4 = 16 * m + 4 * q; const size_t o = ((size_t)b * 512 + c) * 4096 + 64 * a + i4;
            const u32x2 zz = *(const u32x2*)(Zs + (b * 64 + a) * 72 + i4); const u32x2 xx = *(const u32x2*)(X0T + o);
            const float y0 = acc[m][n][0] * inorm + bflo(zz.x) * skip, y1 = acc[m][n][1] * inorm + bfhi(zz.x) * skip, y2 = acc[m][n][2] * inorm + bflo(zz.y) * skip, y3 = acc[m][n][3] * inorm + bfhi(zz.y) * skip;
            u32x2 w2; w2.x = pk2(bflo(xx.x) * y0, bfhi(xx.x) * y1); w2.y = pk2(bflo(xx.y) * y2, bfhi(xx.y) * y3);
            *(u32x2*)(ZT + o) = w2; }
    __syncthreads();
}

template <int L>
DI void hy_conv(const Params& p, int l, int c, unsigned char* lds, int tid) {
    constexpr int NI = L >= 512 ? L / 512 : 1;
    float* zs = (float*)lds;
    float* gg = zs + L * 4;
    const bool isl = (L == 4096);
    bf16_t* ZT = (bf16_t*)(p.ws + WS_H + (size_t)14 * MSU) + (isl ? 0 : (size_t)4 * 512 * 4096);
    const bf16_t* X0T = (const bf16_t*)(p.ws + WS_H + (size_t)15 * MSU) + (isl ? 0 : (size_t)4 * 512 * 4096);
    const float* HG = (const float*)(p.ws + (isl ? WS_HGL : WS_HGC));
    const float inorm = ((const float*)(p.ws + WS_INORM))[(isl ? 0 : 512) + c];
    const float skip = p.in[17][l * 512 + c];
    __syncthreads();
    for (int idx = tid; idx < L * 4; idx += 512) { const int b = idx / L, t = idx % L; zs[t * 4 + b] = bf2f(ZT[((size_t)b * 512 + c) * L + t]); }
    for (int idx = tid; idx < 2 * L - 1; idx += 512) { const int dd = idx - (L - 1); gg[idx] = dd >= 0 ? HG[(size_t)c * L + dd] : HG[(size_t)(512 + c) * L - dd]; }
    __syncthreads();
    f32x4 acc[NI];
#pragma unroll
    for (int i = 0; i < NI; ++i) acc[i] = (f32x4){0.f, 0.f, 0.f, 0.f};
    const bool act = tid < L;
    if (act) {
        const float* gp = gg + (L - 1) + tid;
#pragma unroll 4
        for (int s = 0; s < L; ++s) { const f32x4 z4 = *(const f32x4*)(zs + 4 * s);
#pragma unroll
            for (int i = 0; i < NI; ++i) acc[i] += z4 * gp[512 * i - s]; }
#pragma unroll
        for (int i = 0; i < NI; ++i) { const int t = tid + 512 * i; const f32x4 z4 = *(const f32x4*)(zs + 4 * t);
#pragma unroll
            for (int b = 0; b < 4; ++b) { const size_t o = ((size_t)b * 512 + c) * L + t; const float y = acc[i][b] * inorm + z4[b] * skip; ZT[o] = f2bf(bf2f(X0T[o]) * y); } }
    }
    __syncthreads();
}

DI void ph_post(const Params& p, int l, unsigned char* lds, int gw, int ngw, int lane, int wave, int M) {
    const bf16_t* PX = (const bf16_t*)(p.ws + WS_PX); bf16_t* CAT = (bf16_t*)(p.ws + WS_A);
    const int ch = lane * 8;
    for (int row = gw * ((M + ngw - 1) / ngw), rend_ = (row + (M + ngw - 1) / ngw < M) ? row + (M + ngw - 1) / ngw : M; row < rend_; ++row) {
        float out[8];
#pragma unroll
        for (int e = 0; e < 8; ++e) out[e] = 0.f;
        const int t = row < T_LAT ? (row & 4095) : ((row - T_LAT) & 255); const int L = row < T_LAT ? 4096 : 256;
#pragma unroll 1
        for (int d = 0; d < 2; ++d) {
            const bool valid = d ? (t < L - 1) : (t > 0); const int pr = d ? row + 1 : row - 1;
            const float* mu = p.in[18] + (size_t)(l * 2 + d) * 1792; const int po = (l * 2 + d) * 512 + ch;
            const bf16_t* q = PX + (size_t)row * NINP + RWO + ch; const bf16_t* qp = PX + (size_t)(valid ? pr : row) * NINP + RWO + ch;
            const u32x4 ur = *(const u32x4*)q, uk = *(const u32x4*)(q + 512), uv = *(const u32x4*)(q + 1024);
            u32x4 pr4 = *(const u32x4*)qp, pk4 = *(const u32x4*)(qp + 512), pv4 = *(const u32x4*)(qp + 1024);
            const u32x4 ua = *(const u32x4*)((const bf16_t*)(p.ws + WS_H + (size_t)(2 + d) * MSU) + (size_t)row * 512 + ch);
            const u32x4 ug = *(const u32x4*)((const bf16_t*)(p.ws + WS_H + (size_t)(4 + d) * MSU) + (size_t)row * 512 + ch);
            const u32x4 uy = *(const u32x4*)((const bf16_t*)(p.ws + WS_H + (size_t)(6 + d) * MSU) + (size_t)row * 512 + ch);
            float r[8], k[8], v[8], a[8], g[8], y[8];
#pragma unroll
            for (int e = 0; e < 4; ++e) {
                const float r0 = bflo(ur[e]), r1 = bfhi(ur[e]), k0 = bflo(uk[e]), k1 = bfhi(uk[e]), v0 = bflo(uv[e]), v1 = bfhi(uv[e]);
                const float pr0 = valid ? bflo(pr4[e]) : 0.f, pr1 = valid ? bfhi(pr4[e]) : 0.f, pk0 = valid ? bflo(pk4[e]) : 0.f, pk1 = valid ? bfhi(pk4[e]) : 0.f, pv0 = valid ? bflo(pv4[e]) : 0.f, pv1 = valid ? bfhi(pv4[e]) : 0.f;
                r[2 * e] = r0 + (pr0 - r0) * mu[ch + 2 * e]; r[2 * e + 1] = r1 + (pr1 - r1) * mu[ch + 2 * e + 1];
                k[2 * e] = k0 + (pk0 - k0) * mu[512 + ch + 2 * e]; k[2 * e + 1] = k1 + (pk1 - k1) * mu[512 + ch + 2 * e + 1];
                v[2 * e] = v0 + (pv0 - v0) * mu[1024 + ch + 2 * e]; v[2 * e + 1] = v1 + (pv1 - v1) * mu[1024 + ch + 2 * e + 1];
                a[2 * e] = bflo(ua[e]); a[2 * e + 1] = bfhi(ua[e]); g[2 * e] = bflo(ug[e]); g[2 * e + 1] = bfhi(ug[e]); y[2 * e] = bflo(uy[e]); y[2 * e + 1] = bfhi(uy[e]); }
            float bs = 0.f, sy = 0.f;
#pragma unroll
            for (int e = 0; e < 8; ++e) { const float kp = k[e] * (1.f + (a[e] - 1.f) * p.in[25][po + e]); bs += r[e] * kp * p.in[26][po + e]; sy += y[e]; }
            bs += DPPF(bs, 0xB1); bs += DPPF(bs, 0x4E); bs += DPPF(bs, 0x141);
            sy += DPPF(sy, 0xB1); sy += DPPF(sy, 0x4E); sy += DPPF(sy, 0x141);
            const float mean = sy * (1.f / 64.f); float sv = 0.f;
#pragma unroll
            for (int e = 0; e < 8; ++e) { const float dd = y[e] - mean; sv += dd * dd; }
            sv += DPPF(sv, 0xB1); sv += DPPF(sv, 0x4E); sv += DPPF(sv, 0x141);
            const float rstd = rsqrtf(sv * (1.f / 64.f) + 64e-5f);
#pragma unroll
            for (int e = 0; e < 8; ++e) out[e] += ((y[e] - mean) * rstd * p.in[27][po + e] + p.in[28][po + e] + bs * v[e]) * g[e];
        }
        { u32x4 w; w.x = pk2(out[0], out[1]); w.y = pk2(out[2], out[3]); w.z = pk2(out[4], out[5]); w.w = pk2(out[6], out[7]); *(u32x4*)(CAT + (size_t)row * DM + 512 + ch) = w; }
        { const u32x4 o0 = *(const u32x4*)((const bf16_t*)(p.ws + WS_H + (size_t)8 * MSU) + (size_t)row * 512 + ch);
          const u32x4 o1 = *(const u32x4*)((const bf16_t*)(p.ws + WS_H + (size_t)9 * MSU) + (size_t)row * 512 + ch);
          const u32x4 uz = *(const u32x4*)(PX + (size_t)row * NINP + GDO + 1536 + ch);
          float o[8], z[8]; float ss = 0.f;
#pragma unroll
          for (int e = 0; e < 4; ++e) { o[2 * e] = bflo(o0[e]) + bflo(o1[e]); o[2 * e + 1] = bfhi(o0[e]) + bfhi(o1[e]); z[2 * e] = bflo(uz[e]); z[2 * e + 1] = bfhi(uz[e]); }
#pragma unroll
          for (int e = 0; e < 8; ++e) ss += o[e] * o[e];
          ss += DPPF(ss, 0xB1); ss += DPPF(ss, 0x4E); ss += DPPF(ss, 0x141); ss += DPPF(ss, 0x140);
          const float rs = rsqrtf(ss * (1.f / 128.f) + 1e-6f);
#pragma unroll
          for (int e = 0; e < 8; ++e) o[e] = o[e] * rs * p.in[32][l * 128 + ((ch + e) & 127)] * siluf(z[e]);
          u32x4 w; w.x = pk2(o[0], o[1]); w.y = pk2(o[2], o[3]); w.z = pk2(o[4], o[5]); w.w = pk2(o[6], o[7]); *(u32x4*)(CAT + (size_t)row * DM + 1024 + ch) = w; }
    }
    for (int row = gw * ((M + ngw - 1) / ngw), rend_ = (row + (M + ngw - 1) / ngw < M) ? row + (M + ngw - 1) / ngw : M; row < rend_; ++row) {
        const u32x4 hf = *(const u32x4*)((const bf16_t*)(p.ws + WS_H + (size_t)10 * MSU) + (size_t)row * 512 + ch);
        const u32x4 hb = *(const u32x4*)((const bf16_t*)(p.ws + WS_H + (size_t)11 * MSU) + (size_t)row * 512 + ch);
        const u32x4 ug = *(const u32x4*)(PX + (size_t)row * NINP + RGO + 512 + ch);
        u32x4 w;
#pragma unroll
        for (int e = 0; e < 4; ++e) w[e] = pk2(gelu_tanh(bflo(ug[e])) * (bflo(hf[e]) + bflo(hb[e])), gelu_tanh(bfhi(ug[e])) * (bfhi(hf[e]) + bfhi(hb[e])));
        *(u32x4*)(CAT + (size_t)row * DM + 1536 + ch) = w; }
    bf16_t* tile = (bf16_t*)(lds + wave * (64 * 66 * 2));
    const bf16_t* OT = (const bf16_t*)(p.ws + WS_H + (size_t)14 * MSU);
    const int nit = (M > T_LAT) ? 2048 + 128 : 2048;
    for (int it = gw; it < nit; it += ngw) {
        int b, t0, c0, L, rowb; size_t base;
        if (it < 2048) { b = it >> 9; t0 = ((it >> 3) & 63) * 64; c0 = (it & 7) * 64; L = 4096; rowb = b * 4096; base = 0; }
        else { const int ic = it - 2048; b = ic >> 5; t0 = ((ic >> 3) & 3) * 64; c0 = (ic & 7) * 64; L = 256; rowb = T_LAT + b * 256; base = (size_t)4 * 512 * 4096; }
        for (int i = 0; i < 64; ++i) tile[i * 66 + lane] = OT[base + ((size_t)b * 512 + c0 + i) * L + t0 + lane];
        LDSW();
        for (int j = 0; j < 64; ++j) CAT[(size_t)(rowb + t0 + j) * DM + c0 + lane] = tile[lane * 66 + j];
        LDSW();
    }
}

DI void ph_final(const Params& p, int gw, int ngw, int lane) {
    const float* g = p.in[42];
    f32x4 gg[8];
#pragma unroll
    for (int j = 0; j < 8; ++j) gg[j] = *(const f32x4*)(g + 4 * lane + 256 * j);
    const int nrow = (T_LAT + ngw - 1) / ngw; const int r0 = gw * nrow, r1 = (r0 + nrow < T_LAT) ? r0 + nrow : T_LAT;
    if (r0 >= r1) return;
    f32x4 v[8], vn[8];
#pragma unroll
    for (int j = 0; j < 8; ++j) v[j] = *(const f32x4*)(p.out + (size_t)r0 * DM + 4 * lane + 256 * j);
    for (int r = r0; r < r1; ++r) { const int rn = (r + 1 < r1) ? r + 1 : r;
#pragma unroll
        for (int j = 0; j < 8; ++j) vn[j] = *(const f32x4*)(p.out + (size_t)rn * DM + 4 * lane + 256 * j);
        float ss = 0.f;
#pragma unroll
        for (int j = 0; j < 8; ++j) ss += (v[j][0] * v[j][0] + v[j][1] * v[j][1]) + (v[j][2] * v[j][2] + v[j][3] * v[j][3]);
        ss = wave_sum_fast(ss); const float rs = rsqrtf(ss * (1.f / 2048.f) + 1e-6f);
#pragma unroll
        for (int j = 0; j < 8; ++j) *(f32x4*)(p.out + (size_t)r * DM + 4 * lane + 256 * j) = v[j] * rs * gg[j];
#pragma unroll
        for (int j = 0; j < 8; ++j) v[j] = vn[j]; }
}

#define LAS __attribute__((address_space(3)))
#define XB_TMO      128
#define XB_XCNT(j)  (256  + 64 * (j))
#define XB_XSUB(j)  (1280 + 64 * (j))
#define XB_XGEN(j)  (2304 + 64 * (j))
#define XB_TOP      3328
#define XB_TOPGEN   3392
#define XCD_BAR_WORDS 3456
#define XB_SPIN_CAP (1u << 18)

__device__ __forceinline__ unsigned xb_ld(unsigned* p)              { return __hip_atomic_load(p, __ATOMIC_RELAXED, __HIP_MEMORY_SCOPE_AGENT); }
__device__ __forceinline__ unsigned xb_add(unsigned* p, unsigned v) { return __hip_atomic_fetch_add(p, v, __ATOMIC_RELAXED, __HIP_MEMORY_SCOPE_AGENT); }
__device__ __forceinline__ unsigned xb_xcc_id() { return (unsigned)__builtin_amdgcn_s_getreg((3 << 11) | 20) & 0xFu; }
#define XB_SPIN(cond, bar) do { unsigned _sp = 0; while (cond) { __builtin_amdgcn_s_sleep(1); \
    if ((++_sp & 255u) == 0u) { if (xb_ld(&(bar)[XB_TMO])) break; if (_sp > XB_SPIN_CAP) { atomicAdd(&(bar)[XB_TMO], 1u); break; } } } } while (0)

struct XcdBarrier {
    unsigned* bar; unsigned x;
    volatile LAS unsigned* st;
};

__device__ __forceinline__ XcdBarrier xcd_barrier_post(unsigned* bar, volatile LAS unsigned* st) {
    XcdBarrier b; b.bar = bar; b.x = xb_xcc_id(); b.st = st;
    if (threadIdx.x == 0) (void)xb_add(&bar[XB_XCNT(b.x)], 1u);
    return b;
}
__device__ __forceinline__ void xcd_barrier_complete(unsigned* bar, unsigned x, unsigned& nloc, unsigned& nx) {
    const unsigned G = gridDim.x * gridDim.y * gridDim.z;
    unsigned sum, cnt, mine, sp = 0u;
    for (;;) {
        sum = 0u; cnt = 0u; mine = 0u;
#pragma unroll
        for (unsigned j = 0; j < 16; ++j) { const unsigned c = xb_ld(&bar[XB_XCNT(j)]); sum += c; cnt += (c > 0u) ? 1u : 0u; mine = (j == x) ? c : mine; }
        if (sum == G) break;
        __builtin_amdgcn_s_sleep(1);
        if ((++sp & 255u) == 0u) { if (xb_ld(&bar[XB_TMO])) break; if (sp > XB_SPIN_CAP) { atomicAdd(&bar[XB_TMO], 1u); break; } }
    }
    nloc = mine > 0u ? mine : 1u; nx = cnt > 0u ? cnt : 1u;
}

__device__ __forceinline__ void xcd_barrier(const XcdBarrier& b) {
    asm volatile("s_waitcnt vmcnt(0)" ::: "memory");
    __syncthreads();
    if (threadIdx.x == 0) {
        unsigned* bar = b.bar;
        __builtin_amdgcn_s_waitcnt(0);
        unsigned nloc = b.st[0], nx = b.st[1];
        if (nloc == 0u) { xcd_barrier_complete(bar, b.x, nloc, nx); b.st[0] = nloc; b.st[1] = nx; }
        const unsigned old = xb_add(&bar[XB_XSUB(b.x)], 1u);
        const unsigned gen = old / nloc;
        if (old + 1u == (gen + 1u) * nloc) {
            __builtin_amdgcn_fence(__ATOMIC_RELEASE, "agent");
            asm volatile("s_waitcnt vmcnt(0)" ::: "memory");
            const unsigned og = xb_add(&bar[XB_TOP], 1u);
            const unsigned tg = og / nx;
            if (og + 1u == (tg + 1u) * nx) xb_add(&bar[XB_TOPGEN], 1u);
            else XB_SPIN(xb_ld(&bar[XB_TOPGEN]) == tg, bar);
            __builtin_amdgcn_fence(__ATOMIC_ACQUIRE, "agent");
            xb_add(&bar[XB_XGEN(b.x)], 1u);
            asm volatile("s_waitcnt vmcnt(0)" ::: "memory");
        } else {
            XB_SPIN(xb_ld(&bar[XB_XGEN(b.x)]) == gen, bar);
            __builtin_amdgcn_fence(__ATOMIC_ACQUIRE, "agent");
            asm volatile("s_waitcnt vmcnt(0)" ::: "memory");
        }
    }
    __syncthreads();
}

#ifndef PROBE_SUB
#define PROBE_SUB 255
#endif
template <int K, int REP = 0>
DI void run_phase(const Params& p, const int l, unsigned char* lds) {
    int tid_ = threadIdx.x; asm volatile("" : "+v"(tid_));
    int bid_ = blockIdx.x; asm volatile("" : "+s"(bid_));
    const int tid = tid_, lane = tid & 63, wave = __builtin_amdgcn_readfirstlane(tid >> 6);
    const int G = gridDim.x, bid = bid_, gw = bid * 8 + wave, ngw = G * 8;
    const bool last = (l == 1);
    const int M = last ? T_LAT : T_ALL;
    const float* xl = l == 0 ? p.in[0] : p.out; const float* xc = l == 0 ? p.in[2] : (const float*)(p.ws + WS_XC);
    float* XC = (float*)(p.ws + WS_XC); const float* MOD = (const float*)(p.ws + WS_MOD);
    if constexpr (K == 0) { if (REP == 0 || (PROBE_SUB & 32)) ph_weights(p, l, lds, gw, ngw, wave, lane); __syncthreads(); if (REP == 0 || (PROBE_SUB & 64)) ph_ada_partial(p, l, lds, bid, G, tid); if (REP == 0 || (PROBE_SUB & 128)) ph_hyfilt(p, l, lds, bid, G, tid); }
    else if constexpr (K == 1) { ph_b(p, l, bid, G, tid, gw, ngw, lane); }
    else if constexpr (K == 2) { ph_norm(p, xl, xc, p.in[6] + l * 2048, 0, 1, T_ALL, gw, ngw, lane, (l == 1 && G == 256) ? 5 : -1); }
    else if constexpr (K == 3) {
        pg8::Gemm g{(const bf16_t*)(p.ws + WS_A), (const bf16_t*)(p.ws + WS_WIN), T_ALL, NINP, DM, 0}; pg8::StaticOrder S; S.init(T_ALL, NINP, G, bid);
        EpiStoreBf16 E{(bf16_t*)(p.ws + WS_PX), NINP, 0};
        pg8::gemm_phase<EpiStoreBf16, pg8::StaticOrder, true, true>((PG8_LAS unsigned char*)lds, g, S, E, tid);
    }
    else if constexpr (K == 4) { if (REP == 0 || (PROBE_SUB & 1)) ph_rw_prep(p, l, lds, bid, G, tid); if (REP == 0) ph_gd_prep(p, l, lds, bid, G, tid, lane, wave); if (REP == 0 || (PROBE_SUB & 2)) ph_rg_prep(p, l, lds, bid, G, tid); if (REP == 0 || (PROBE_SUB & 4)) ph_hy_prep(p, l, lds, bid, G, tid); }
    else if constexpr (K == 5) {
        if (bid < 128) {
            if (REP == 0 || (PROBE_SUB & 8)) rw_scan(p, l, (((bid & 7) + 8 * (bid >> 4)) << 1) | ((bid >> 3) & 1), lds, tid, lane, wave);
            if (REP == 0) {
                if (bid >= 64) rg_scan(p, bid - 64, lds, lane, wave);
                for (int c = bid; c < 256; c += 128) hy_conv_mfma(p, l, c, lds, tid);
                if (l == 0) for (int c = bid; c < 512; c += 128) hy_conv<256>(p, l, c, lds, tid); }
        }
        else { const int gi = bid - 128;
            if (REP == 0 || (PROBE_SUB & 16)) gd_scan(p, l, (((gi & 7) + 8 * (gi >> 5)) << 2) | ((gi >> 3) & 3), lds, tid, lane, wave);
            if (REP == 0) for (int c = 256 + (bid - 128); c < 512; c += 128) hy_conv_mfma(p, l, c, lds, tid); }
    }
    else if constexpr (K == 6) { ph_post(p, l, lds, gw, ngw, lane, wave, M); }
    else if constexpr (K == 7) {
        {
            pg8::Gemm g{(const bf16_t*)(p.ws + WS_A), (const bf16_t*)(p.ws + WS_WO), T_LAT, DM, DM, 0}; pg8::StaticOrder S; S.init(T_LAT, DM, G, bid);
            EpiResidual E{xl, xc, p.out, XC, MOD + 2 * 2048};
            pg8::gemm_phase<EpiResidual, pg8::StaticOrder, true, true>((PG8_LAS unsigned char*)lds, g, S, E, tid);
        }
        if (!last && G == 256) {
            const int ks = bid >> 5, u = bid & 31;
            pg8::Gemm g{(const bf16_t*)(p.ws + WS_A) + (size_t)T_LAT * DM + ks * 256, (const bf16_t*)(p.ws + WS_WO) + ks * 256, 1024, DM, 256, DM}; OneUnit S{u >> 3, u & 7};
            EpiSlab E{(float*)(p.ws + WS_PX) + (size_t)ks * 1024 * DM, MOD + 2 * 2048};
            pg8::gemm_phase<EpiSlab, OneUnit, false, true>((PG8_LAS unsigned char*)lds, g, S, E, tid);
        } else if (!last) {
            pg8::Gemm g{(const bf16_t*)(p.ws + WS_A) + (size_t)T_LAT * DM, (const bf16_t*)(p.ws + WS_WO), 1024, DM, DM, 0}; pg8::StaticOrder S; S.init(1024, DM, G, bid);
            EpiResidual E{xc, xc, XC, XC, MOD + 2 * 2048 + 4 * 12288};
            pg8::gemm_phase<EpiResidual, pg8::StaticOrder, true, true>((PG8_LAS unsigned char*)lds, g, S, E, tid);
        }
    }
    else if constexpr (K == 8) { ph_norm(p, p.out, (l == 0 && G == 256) ? p.in[2] : XC, p.in[7] + l * 2048, 3, 4, M, gw, ngw, lane, (l == 0 && G == 256) ? 2 : -1); }
    else if constexpr (K == 9) {
        pg8::Gemm g{(const bf16_t*)(p.ws + WS_A), (const bf16_t*)(p.ws + WS_W1), M, DFF, DM, 0}; pg8::StaticOrder S; S.init(M, DFF, G, bid);
        EpiStoreBf16 E{(bf16_t*)(p.ws + WS_H), DFF, 1};
        pg8::gemm_phase<EpiStoreBf16, pg8::StaticOrder, true, true>((PG8_LAS unsigned char*)lds, g, S, E, tid);
    }
    else if constexpr (K == 10) {
        {
            pg8::Gemm g{(const bf16_t*)(p.ws + WS_H), (const bf16_t*)(p.ws + WS_W2), T_LAT, DM, DFF, 0}; pg8::StaticOrder S; S.init(T_LAT, DM, G, bid);
            EpiResidual E{p.out, XC, p.out, XC, MOD + 5 * 2048};
            pg8::gemm_phase<EpiResidual, pg8::StaticOrder, true, true>((PG8_LAS unsigned char*)lds, g, S, E, tid);
        }
        if (!last && G == 256) {
            const int ks = bid >> 5, u = bid & 31;
            pg8::Gemm g{(const bf16_t*)(p.ws + WS_H) + (size_t)T_LAT * DFF + ks * 1024, (const bf16_t*)(p.ws + WS_W2) + ks * 1024, 1024, DM, 1024, DFF}; OneUnit S{u >> 3, u & 7};
            EpiSlab E{(float*)(p.ws + WS_PX) + (size_t)ks * 1024 * DM, MOD + 5 * 2048};
            pg8::gemm_phase<EpiSlab, OneUnit, false, true>((PG8_LAS unsigned char*)lds, g, S, E, tid);
        } else if (!last) {
            pg8::Gemm g{(const bf16_t*)(p.ws + WS_H) + (size_t)T_LAT * DFF, (const bf16_t*)(p.ws + WS_W2), 1024, DM, DFF, 0}; pg8::StaticOrder S; S.init(1024, DM, G, bid);
            EpiResidual E{XC, XC, XC, XC, MOD + 5 * 2048 + 4 * 12288};
            pg8::gemm_phase<EpiResidual, pg8::StaticOrder, true, true>((PG8_LAS unsigned char*)lds, g, S, E, tid);
        }
    }
    else { ph_final(p, gw, ngw, lane); }
}

#ifndef MK_FUSED
#define MK_FUSED 1
#endif
#if MK_FUSED
__global__ void __launch_bounds__(512) mk_fwd(Params p) {
    extern __shared__ __attribute__((aligned(16))) unsigned char lds[];
    cg::grid_group grid = cg::this_grid();
    if (threadIdx.x < 16) ((unsigned*)(lds + LDS_BYTES - 64))[threadIdx.x] = 0u;
    __syncthreads();
    const XcdBarrier xbar = xcd_barrier_post((unsigned*)(p.ws + WS_BAR), (volatile LAS unsigned*)((LAS unsigned char*)lds + (LDS_BYTES - 64)));
#define GSYNC() do { if (p.out == nullptr) grid.sync(); xcd_barrier(xbar); } while (0)
#ifndef PROBE_DUP
#define PROBE_DUP 0
#endif
#define PHS(K, L) run_phase<K>(p, L, lds); GSYNC(); if ((PROBE_DUP >> K) & 1) { if (!((K == 7 && L == 1) || K == 10)) { run_phase<K, 1>(p, L, lds); GSYNC(); } }
#define LAYER(L) PHS(0, L) PHS(1, L) PHS(2, L) PHS(3, L) PHS(4, L) PHS(5, L) PHS(6, L) PHS(7, L) PHS(8, L) PHS(9, L) PHS(10, L)
    LAYER(0) LAYER(1)
#ifdef PROBE_SYNCS
    for (int i = 0; i < PROBE_SYNCS; ++i) GSYNC();
#endif
    run_phase<11>(p, 1, lds);
}
#else
template <int K> __global__ void __launch_bounds__(512) k_phase(Params p, int l) {
    extern __shared__ __attribute__((aligned(16))) unsigned char lds[];
    run_phase<K>(p, l, lds);
}
template <int K> static void launch_phase(const Params& p, int l, int grid, hipStream_t stream) {
    static bool attr = false;
    if (!attr) { (void)hipFuncSetAttribute((const void*)k_phase<K>, hipFuncAttributeMaxDynamicSharedMemorySize, LDS_BYTES); attr = true; }
    hipLaunchKernelGGL(k_phase<K>, dim3(grid), dim3(512), LDS_BYTES, stream, p, l);
}
#endif

extern "C" void kernel_launch(void* const* d_in, const int* in_sizes, int n_in, void* d_out, int out_size, void* d_ws, size_t ws_size, hipStream_t stream) {
    static int grid_blocks = 0;
    if (grid_blocks == 0) {
        if (n_in != 43 || ws_size < WS_END) { fprintf(stderr, "kernel_launch: unexpected inputs (n_in %d, ws %zu < %zu)\n", n_in, ws_size, (size_t)WS_END); grid_blocks = -1; return; }
        int dev = 0, cus = 0, per_cu = 1;
        (void)hipGetDevice(&dev); (void)hipDeviceGetAttribute(&cus, hipDeviceAttributeMultiprocessorCount, dev);
#if MK_FUSED
        (void)hipFuncSetAttribute((const void*)mk_fwd, hipFuncAttributeMaxDynamicSharedMemorySize, LDS_BYTES);
        (void)hipOccupancyMaxActiveBlocksPerMultiprocessor(&per_cu, (const void*)mk_fwd, 512, LDS_BYTES);
        if (per_cu < 1) per_cu = 1;
#endif
        grid_blocks = cus * per_cu;
        if (grid_blocks > 256) grid_blocks = 256;
    }
    if (grid_blocks < 0) return;
    Params p{};
    for (int i = 0; i < 43; ++i) p.in[i] = (const float*)d_in[i];
    p.out = (float*)d_out; p.ws = (unsigned char*)d_ws;
#if MK_FUSED
    (void)hipMemsetAsync((unsigned char*)d_ws + WS_BAR, 0, 16384, stream);
    void* args[] = {&p};
    hipError_t e = hipLaunchCooperativeKernel((const void*)mk_fwd, dim3(grid_blocks), dim3(512), args, LDS_BYTES, stream);
    if (e != hipSuccess) fprintf(stderr, "cooperative launch failed: %s (grid %d)\n", hipGetErrorString(e), grid_blocks);
#else
    for (int l = 0; l < 2; ++l) {
        launch_phase<0>(p, l, grid_blocks, stream); launch_phase<1>(p, l, grid_blocks, stream); launch_phase<2>(p, l, grid_blocks, stream); launch_phase<3>(p, l, grid_blocks, stream);
        launch_phase<4>(p, l, grid_blocks, stream); launch_phase<5>(p, l, grid_blocks, stream); launch_phase<6>(p, l, grid_blocks, stream); launch_phase<7>(p, l, grid_blocks, stream);
        launch_phase<8>(p, l, grid_blocks, stream); launch_phase<9>(p, l, grid_blocks, stream); launch_phase<10>(p, l, grid_blocks, stream);
    }
    launch_phase<11>(p, 1, grid_blocks, stream);
#endif
}
```
